# Optimizing an MI355X kernel written in HIP

```python
import math
import jax, jax.numpy as jnp
from jax import lax
import numpy as np

D_MODEL = 2048
BATCH = 2
SEQ = 4096
DEPTH = 2
DEC_BATCH = 32
DEC_SEQ = 4
PAST_LEN = 8192
PAGE_SIZE = 128

N_MIXERS = 4
GROUP_W = D_MODEL // N_MIXERS
SSM_CH_PER_GROUP = 16
SSM_GROUPS = GROUP_W // SSM_CH_PER_GROUP
SSM_STATE = 64
CONV_K = 3
POOL_WINDOWS = (2, 4, 8, 16)
POOL_CH = GROUP_W // len(POOL_WINDOWS)
POOL_BUF = max(POOL_WINDOWS) - 1
HEAD_DIM = 64
NSA_HEADS = GROUP_W // HEAD_DIM
KV_HEADS = 2
Q_PER_KV = NSA_HEADS // KV_HEADS
BLOCK = 64
TOP_N = 16
WINDOW = 512
Q_BLOCK = 128
N_BRANCH_KV = 6
KV_COLS = N_BRANCH_KV * KV_HEADS * HEAD_DIM
IN_COLS = 6 * GROUP_W + KV_COLS + 3 * NSA_HEADS
D_FF = 4 * D_MODEL
ALPHA = (2.0 * DEPTH) ** 0.25
BETA = (8.0 * DEPTH) ** -0.25
NEG_INF = -1e30
FORCED_SCORE = Q_PER_KV + 1.0
LN_EPS = 1e-5

kernel_name = 'hybrid_s5_conv_pool_nsa_step'


def layer_norm(x, g, b):
    xf = x.astype(jnp.float32)
    mu = jnp.mean(xf, axis=-1, keepdims=True)
    var = jnp.mean(jnp.square(xf - mu), axis=-1, keepdims=True)
    y = (xf - mu) * lax.rsqrt(var + LN_EPS) * g.astype(jnp.float32) + b.astype(jnp.float32)
    return y.astype(x.dtype)


def _ssm_combine(e1, e2):
    a1r, a1i, b1r, b1i = e1
    a2r, a2i, b2r, b2i = e2
    ar = a2r * a1r - a2i * a1i
    ai = a2r * a1i + a2i * a1r
    br = a2r * b1r - a2i * b1i + b2r
    bi = a2r * b1i + a2i * b1r + b2i
    return (ar, ai, br, bi)


def s5_mixer(u, h0_re, h0_im, a_re, a_im, b_re, b_im, c_re, c_im, d, log_dt, w_glu, b_glu):
    f32 = jnp.float32
    B, T, _ = u.shape
    a_re = a_re.astype(f32)
    a_im = a_im.astype(f32)
    dt = jnp.exp(log_dt.astype(f32))[:, None]
    mag = jnp.exp(dt * a_re)
    ab_re = mag * jnp.cos(dt * a_im)
    ab_im = mag * jnp.sin(dt * a_im)
    den = a_re * a_re + a_im * a_im
    nr = ab_re - 1.0
    f_re = (nr * a_re + ab_im * a_im) / den
    f_im = (ab_im * a_re - nr * a_im) / den
    b_re = b_re.astype(f32)
    b_im = b_im.astype(f32)
    bb_re = f_re[..., None] * b_re - f_im[..., None] * b_im
    bb_im = f_re[..., None] * b_im + f_im[..., None] * b_re
    uf = u.astype(f32)
    ug = uf.reshape(B, T, SSM_GROUPS, SSM_CH_PER_GROUP)
    bu_re = jnp.einsum('gnc,btgc->btgn', bb_re, ug)
    bu_im = jnp.einsum('gnc,btgc->btgn', bb_im, ug)
    shp = bu_re.shape
    elems = (jnp.broadcast_to(ab_re, shp), jnp.broadcast_to(ab_im, shp), bu_re, bu_im)
    acc_re, acc_im, s_re, s_im = lax.associative_scan(_ssm_combine, elems, axis=1)
    h0r = h0_re.astype(f32)[:, None]
    h0i = h0_im.astype(f32)[:, None]
    h_re = s_re + acc_re * h0r - acc_im * h0i
    h_im = s_im + acc_re * h0i + acc_im * h0r
    y = (jnp.einsum('gcn,btgn->btgc', c_re.astype(f32), h_re)
         - jnp.einsum('gcn,btgn->btgc', c_im.astype(f32), h_im))
    y = y.reshape(B, T, GROUP_W) + d.astype(f32) * uf
    y = jax.nn.gelu(y)
    y = y * jax.nn.sigmoid(y @ w_glu.astype(f32) + b_glu.astype(f32))
    return y.astype(u.dtype), h_re[:, -1], h_im[:, -1]


def short_conv_mixer(g_b, g_c, v, prev, conv_w, conv_b):
    T = v.shape[1]
    cv = g_c * v
    ext = jnp.concatenate([prev.astype(cv.dtype), cv], axis=1)
    conv = conv_b
    for j in range(CONV_K):
        conv = conv + conv_w[j] * ext[:, j:j + T]
    return g_b * conv, ext[:, -(CONV_K - 1):]


def pool_mixer(u, prev, n_prev_valid, pool_w, pool_scale):
    f32 = jnp.float32
    B, T, C = u.shape
    ext = jnp.concatenate([prev.astype(u.dtype), u], axis=1)
    cs = jnp.concatenate([jnp.zeros((B, 1, C), f32), jnp.cumsum(ext.astype(f32), axis=1)], axis=1)
    hi = cs[:, POOL_BUF + 1:]
    t = jnp.arange(T)
    outs = []
    for gi, w in enumerate(POOL_WINDOWS):
        sl = slice(gi * POOL_CH, (gi + 1) * POOL_CH)
        lo = cs[:, POOL_BUF + 1 - w:POOL_BUF + 1 - w + T, sl]
        cnt = jnp.minimum(t + 1 + n_prev_valid, w).astype(f32)[None, :, None]
        outs.append((hi[..., sl] - lo) / cnt)
    pooled = jnp.concatenate(outs, axis=-1) - u.astype(f32)
    y = jnp.einsum('btgc,gcd->btgd', pooled.reshape(B, T, len(POOL_WINDOWS), POOL_CH), pool_w.astype(f32))
    y = y.reshape(B, T, C) * pool_scale.astype(f32)
    return y.astype(u.dtype), ext[:, -POOL_BUF:]


def compress_blocks(k, w):
    B, L, G, D = k.shape
    kb = k.reshape(B, L // BLOCK, BLOCK, G, D)
    return jnp.einsum('bjkgd,kd->bjgd', kb, w)


def nsa_compressed_branch(q, q_pos, k_cmp, v_cmp, w_ck, w_cv):
    B, T, H, D = q.shape
    kc = compress_blocks(k_cmp, w_ck)
    vc = compress_blocks(v_cmp, w_cv)
    NB = kc.shape[1]
    qg = q.reshape(B, T, KV_HEADS, Q_PER_KV, D)
    s = jnp.einsum('btgrd,bjgd->bgrtj', qg, kc).astype(jnp.float32) * (HEAD_DIM ** -0.5)
    j = jnp.arange(NB)
    complete = ((j + 1) * BLOCK - 1)[None, :] <= q_pos[:, None]
    s = jnp.where(complete, s, NEG_INF)
    p = jnp.where(complete, jax.nn.softmax(s, axis=-1), 0.0)
    o = jnp.einsum('bgrtj,bjgd->btgrd', p.astype(vc.dtype), vc).reshape(B, T, H, D)
    imp = jnp.sum(p, axis=2)
    cur = q_pos // BLOCK
    forced = (j[None, :] == 0) | (j[None, :] == cur[:, None]) | (j[None, :] == cur[:, None] - 1)
    started = (j * BLOCK)[None, :] <= q_pos[:, None]
    score = jnp.where(forced, FORCED_SCORE, jnp.where(started, imp, -1.0))
    _, idx = lax.top_k(score, min(TOP_N, NB))
    return o, idx


def nsa_selected_branch(q, q_pos, k_sel, v_sel, idx):
    B, T, H, D = q.shape
    L = k_sel.shape[1]
    kb = k_sel.reshape(B, L // BLOCK, BLOCK, KV_HEADS, D).transpose(0, 3, 1, 2, 4)
    vb = v_sel.reshape(B, L // BLOCK, BLOCK, KV_HEADS, D).transpose(0, 3, 1, 2, 4)
    qb = min(Q_BLOCK, T)
    nq = T // qb
    n_sel = idx.shape[-1]
    gather = jax.vmap(jax.vmap(lambda tbl, ii: tbl[ii]))

    def one(args):
        qc, pc, ic = args
        kg = gather(kb, ic)
        vg = gather(vb, ic)
        kpos = ic[..., None] * BLOCK + jnp.arange(BLOCK)
        s = jnp.einsum('bqgrd,bgqnkd->bgrqnk', qc.reshape(B, qb, KV_HEADS, Q_PER_KV, D), kg)
        s = s.astype(jnp.float32) * (HEAD_DIM ** -0.5)
        mask = (kpos <= pc[None, None, :, None, None])[:, :, None]
        s = jnp.where(mask, s, NEG_INF).reshape(B, KV_HEADS, Q_PER_KV, qb, n_sel * BLOCK)
        p = jax.nn.softmax(s, axis=-1).reshape(B, KV_HEADS, Q_PER_KV, qb, n_sel, BLOCK)
        o = jnp.einsum('bgrqnk,bgqnkd->bqgrd', p.astype(vg.dtype), vg)
        return o.reshape(B, qb, H, D)

    qs = q.reshape(B, nq, qb, H, D).transpose(1, 0, 2, 3, 4)
    ps = q_pos.reshape(nq, qb)
    ids = idx.reshape(B, KV_HEADS, nq, qb, n_sel).transpose(2, 0, 1, 3, 4)
    out = lax.map(one, (qs, ps, ids))
    return out.transpose(1, 0, 2, 3, 4).reshape(B, T, H, D)


def nsa_window_branch(q, q_pos, k_ext, v_ext, kpos_ext, n_prev):
    B, T, H, D = q.shape
    qb = min(Q_BLOCK, T)
    nq = T // qb
    span = n_prev + qb

    def one(args):
        c, qc, pc = args
        start = c * qb
        kc = lax.dynamic_slice_in_dim(k_ext, start, span, axis=1)
        vc = lax.dynamic_slice_in_dim(v_ext, start, span, axis=1)
        kp = lax.dynamic_slice_in_dim(kpos_ext, start, span, axis=0)
        s = jnp.einsum('bqgrd,bkgd->bgrqk', qc.reshape(B, qb, KV_HEADS, Q_PER_KV, D), kc)
        s = s.astype(jnp.float32) * (HEAD_DIM ** -0.5)
        rel = pc[:, None] - kp[None, :]
        mask = (rel >= 0) & (rel < WINDOW) & (kp[None, :] >= 0)
        p = jax.nn.softmax(jnp.where(mask, s, NEG_INF), axis=-1)
        o = jnp.einsum('bgrqk,bkgd->bqgrd', p.astype(vc.dtype), vc)
        return o.reshape(B, qb, H, D)

    qs = q.reshape(B, nq, qb, H, D).transpose(1, 0, 2, 3, 4)
    ps = q_pos.reshape(nq, qb)
    out = lax.map(one, (jnp.arange(nq), qs, ps))
    return out.transpose(1, 0, 2, 3, 4).reshape(B, T, H, D)


def trunk_layer(x, lp, pos0, h0_re, h0_im, conv_prev, pool_prev, pool_prev_valid, past_kv, win_prev):
    B, T, _ = x.shape
    q_pos = pos0 + jnp.arange(T)
    h = x @ lp['w_in']
    sizes = (GROUP_W, GROUP_W, GROUP_W, GROUP_W, GROUP_W, GROUP_W, KV_COLS)
    cuts = [int(c) for c in np.cumsum(sizes)]
    u_ssm, g_b, g_c, v_conv, u_pool, q, kv, g_nsa = jnp.split(h, cuts, axis=-1)
    y_a, h_re, h_im = s5_mixer(u_ssm, h0_re, h0_im, lp['ssm_a_re'], lp['ssm_a_im'], lp['ssm_b_re'],
                               lp['ssm_b_im'], lp['ssm_c_re'], lp['ssm_c_im'], lp['ssm_d'],
                               lp['ssm_log_dt'], lp['ssm_w_glu'], lp['ssm_b_glu'])
    y_b, conv_new = short_conv_mixer(g_b, g_c, v_conv, conv_prev, lp['conv_w'], lp['conv_b'])
    y_c, pool_new = pool_mixer(u_pool, pool_prev, pool_prev_valid, lp['pool_w'], lp['pool_scale'])
    q = q.reshape(B, T, NSA_HEADS, HEAD_DIM)
    kv = kv.reshape(B, T, N_BRANCH_KV, KV_HEADS, HEAD_DIM)
    gates = jax.nn.sigmoid(g_nsa.astype(jnp.float32)).reshape(B, T, NSA_HEADS, 3).astype(x.dtype)
    rows = kv[:, :, :4]
    full = jnp.concatenate([past_kv.astype(rows.dtype), rows], axis=1)
    pad = (-full.shape[1]) % BLOCK
    full = jnp.pad(full, ((0, 0), (0, pad), (0, 0), (0, 0), (0, 0)))
    win_ext = jnp.concatenate([win_prev.astype(kv.dtype), kv[:, :, 4:]], axis=1)
    n_prev = win_prev.shape[1]
    kpos_ext = jnp.arange(n_prev + T) + (pos0 - n_prev)
    o_cmp, idx = nsa_compressed_branch(q, q_pos, full[:, :, 0], full[:, :, 1], lp['nsa_w_cmp_k'], lp['nsa_w_cmp_v'])
    o_sel = nsa_selected_branch(q, q_pos, full[:, :, 2], full[:, :, 3], idx)
    o_win = nsa_window_branch(q, q_pos, win_ext[:, :, 0], win_ext[:, :, 1], kpos_ext, n_prev)
    y_d = (gates[..., 0:1] * o_cmp + gates[..., 1:2] * o_sel + gates[..., 2:3] * o_win).reshape(B, T, GROUP_W)
    mix = jnp.concatenate([y_a, y_b, y_c, y_d], axis=-1) @ lp['w_out']
    x = layer_norm(ALPHA * x + mix, lp['ln1_g'], lp['ln1_b'])
    ff = jnp.square(jax.nn.relu(x @ lp['w_up'])) @ lp['w_down']
    x = layer_norm(ALPHA * x + ff, lp['ln2_g'], lp['ln2_b'])
    n_keep = min(n_prev, pos0 + T)
    return x, (rows, win_ext[:, -n_keep:], h_re, h_im, conv_new, pool_new)


def setup_inputs(seed: int = 0) -> dict:
    key = jax.random.key(seed)
    k = jax.random.split(key, 32)
    f32 = jnp.float32

    def nrm(i, shape, scale):
        return scale * jax.random.normal(k[i], shape, f32)

    n_pages = PAST_LEN // PAGE_SIZE
    n_used = DEC_BATCH * n_pages
    n_pool = n_used + max(1, n_used // 4)
    w_buf = min(WINDOW, PAST_LEN)
    page_table = jax.random.permutation(k[8], n_pool)[:n_used].reshape(DEC_BATCH, n_pages).astype(jnp.int32)
    a_im = jnp.broadcast_to(math.pi * jnp.arange(SSM_STATE, dtype=f32), (DEPTH, SSM_GROUPS, SSM_STATE))
    return {
        'x_prompt': nrm(0, (BATCH, SEQ, D_MODEL), 1.0),
        'x_sample': nrm(1, (DEC_BATCH, DEC_SEQ, D_MODEL), 1.0),
        'cache_nsa_kv': nrm(2, (DEPTH, n_pool, PAGE_SIZE, 4, KV_HEADS, HEAD_DIM), 1.0),
        'cache_win_kv': nrm(3, (DEPTH, DEC_BATCH, w_buf, 2, KV_HEADS, HEAD_DIM), 1.0),
        'state_ssm_re': nrm(4, (DEPTH, DEC_BATCH, SSM_GROUPS, SSM_STATE), 0.3),
        'state_ssm_im': nrm(5, (DEPTH, DEC_BATCH, SSM_GROUPS, SSM_STATE), 0.3),
        'state_conv': nrm(6, (DEPTH, DEC_BATCH, CONV_K - 1, GROUP_W), 1.0),
        'state_pool': nrm(7, (DEPTH, DEC_BATCH, POOL_BUF, GROUP_W), 1.0),
        'page_table': page_table,
        'w_in': nrm(9, (DEPTH, D_MODEL, IN_COLS), D_MODEL ** -0.5),
        'ssm_a_re': -0.5 * jnp.exp(nrm(10, (DEPTH, SSM_GROUPS, SSM_STATE), 0.02)),
        'ssm_a_im': a_im,
        'ssm_b_re': nrm(11, (DEPTH, SSM_GROUPS, SSM_STATE, SSM_CH_PER_GROUP), (2 * SSM_CH_PER_GROUP) ** -0.5),
        'ssm_b_im': nrm(12, (DEPTH, SSM_GROUPS, SSM_STATE, SSM_CH_PER_GROUP), (2 * SSM_CH_PER_GROUP) ** -0.5),
        'ssm_c_re': nrm(13, (DEPTH, SSM_GROUPS, SSM_CH_PER_GROUP, SSM_STATE), (2 * SSM_STATE) ** -0.5),
        'ssm_c_im': nrm(14, (DEPTH, SSM_GROUPS, SSM_CH_PER_GROUP, SSM_STATE), (2 * SSM_STATE) ** -0.5),
        'ssm_d': nrm(15, (DEPTH, GROUP_W), 1.0),
        'ssm_log_dt': jax.random.uniform(k[16], (DEPTH, SSM_GROUPS), f32, math.log(1e-3), math.log(1e-1)),
        'ssm_w_glu': nrm(17, (DEPTH, GROUP_W, GROUP_W), GROUP_W ** -0.5),
        'ssm_b_glu': nrm(18, (DEPTH, GROUP_W), 0.01),
        'conv_w': nrm(19, (DEPTH, CONV_K, GROUP_W), CONV_K ** -0.5),
        'conv_b': nrm(20, (DEPTH, GROUP_W), 0.01),
        'pool_w': nrm(21, (DEPTH, len(POOL_WINDOWS), POOL_CH, POOL_CH), POOL_CH ** -0.5),
        'pool_scale': 1.0 + nrm(22, (DEPTH, GROUP_W), 0.1),
        'nsa_w_cmp_k': (1.0 + nrm(23, (DEPTH, BLOCK, HEAD_DIM), 0.1)) / BLOCK,
        'nsa_w_cmp_v': (1.0 + nrm(24, (DEPTH, BLOCK, HEAD_DIM), 0.1)) / BLOCK,
        'w_out': nrm(25, (DEPTH, D_MODEL, D_MODEL), BETA * D_MODEL ** -0.5),
        'ln1_g': 1.0 + nrm(26, (DEPTH, D_MODEL), 0.05),
        'ln1_b': nrm(27, (DEPTH, D_MODEL), 0.01),
        'w_up': nrm(28, (DEPTH, D_MODEL, D_FF), D_MODEL ** -0.5),
        'w_down': nrm(29, (DEPTH, D_FF, D_MODEL), BETA * D_FF ** -0.5),
        'ln2_g': 1.0 + nrm(30, (DEPTH, D_MODEL), 0.05),
        'ln2_b': nrm(31, (DEPTH, D_MODEL), 0.01),
    }


def reference(x_prompt, x_sample, cache_nsa_kv, cache_win_kv, state_ssm_re, state_ssm_im, state_conv,
              state_pool, page_table, w_in, ssm_a_re, ssm_a_im, ssm_b_re, ssm_b_im, ssm_c_re, ssm_c_im,
              ssm_d, ssm_log_dt, ssm_w_glu, ssm_b_glu, conv_w, conv_b, pool_w, pool_scale, nsa_w_cmp_k,
              nsa_w_cmp_v, w_out, ln1_g, ln1_b, w_up, w_down, ln2_g, ln2_b):
    B, T, _ = x_prompt.shape
    Bd = x_sample.shape[0]
    n_pages = page_table.shape[1]
    past_len = n_pages * cache_nsa_kv.shape[2]
    xp = x_prompt
    xs = x_sample
    kv_p, kv_s, win_p, win_s = [], [], [], []
    sre_p, sim_p, sre_s, sim_s = [], [], [], []
    conv_p, conv_s, pool_p, pool_s = [], [], [], []
    for l in range(DEPTH):
        lp = {'w_in': w_in[l], 'ssm_a_re': ssm_a_re[l], 'ssm_a_im': ssm_a_im[l], 'ssm_b_re': ssm_b_re[l],
              'ssm_b_im': ssm_b_im[l], 'ssm_c_re': ssm_c_re[l], 'ssm_c_im': ssm_c_im[l], 'ssm_d': ssm_d[l],
              'ssm_log_dt': ssm_log_dt[l], 'ssm_w_glu': ssm_w_glu[l], 'ssm_b_glu': ssm_b_glu[l],
              'conv_w': conv_w[l], 'conv_b': conv_b[l], 'pool_w': pool_w[l], 'pool_scale': pool_scale[l],
              'nsa_w_cmp_k': nsa_w_cmp_k[l], 'nsa_w_cmp_v': nsa_w_cmp_v[l], 'w_out': w_out[l],
              'ln1_g': ln1_g[l], 'ln1_b': ln1_b[l], 'w_up': w_up[l], 'w_down': w_down[l],
              'ln2_g': ln2_g[l], 'ln2_b': ln2_b[l]}
        xp, st = trunk_layer(
            xp, lp, 0,
            jnp.zeros((B, SSM_GROUPS, SSM_STATE), jnp.float32),
            jnp.zeros((B, SSM_GROUPS, SSM_STATE), jnp.float32),
            jnp.zeros((B, CONV_K - 1, GROUP_W), xp.dtype),
            jnp.zeros((B, POOL_BUF, GROUP_W), xp.dtype), 0,
            jnp.zeros((B, 0, 4, KV_HEADS, HEAD_DIM), xp.dtype),
            jnp.zeros((B, WINDOW, 2, KV_HEADS, HEAD_DIM), xp.dtype))
        kv_p.append(st[0]); win_p.append(st[1]); sre_p.append(st[2]); sim_p.append(st[3])
        conv_p.append(st[4]); pool_p.append(st[5])
        past = cache_nsa_kv[l][page_table].reshape(Bd, past_len, 4, KV_HEADS, HEAD_DIM)
        xs, st = trunk_layer(
            xs, lp, past_len, state_ssm_re[l], state_ssm_im[l], state_conv[l], state_pool[l],
            min(POOL_BUF, past_len), past, cache_win_kv[l])
        kv_s.append(st[0]); win_s.append(st[1]); sre_s.append(st[2]); sim_s.append(st[3])
        conv_s.append(st[4]); pool_s.append(st[5])
    return (xp, xs, jnp.stack(kv_p), jnp.stack(kv_s), jnp.stack(win_p), jnp.stack(win_s),
            jnp.stack(sre_p), jnp.stack(sim_p), jnp.stack(sre_s), jnp.stack(sim_s),
            jnp.stack(conv_p), jnp.stack(conv_s), jnp.stack(pool_p), jnp.stack(pool_s))
```

```cpp
#include <hip/hip_runtime.h>
#include <cstdio>
#include <cstdint>

constexpr int DM = 2048, TP = 4096, MP = 8192, SBAT = 32, STOK = 4, MS = 128, MT = MP + MS, MPAD = 8448;
constexpr int NIN = 3864, NINP = 4096, DFF = 8192, GW = 512;
constexpr int PAST = 8192, NPOOLPG = 2560, NPG = 64;
constexpr int C_USSM = 0, C_GB = 512, C_GC = 1024, C_VC = 1536, C_UP = 2048, C_Q = 2560, C_KV = 3072, C_GATE = 3840;
constexpr float ALPHA = 1.4142135623730951f;
constexpr float LN_EPS = 1e-5f;
constexpr float NEGF = -1e30f;
constexpr size_t O_YP = 0, O_YS = O_YP + (size_t)MP * DM, O_KVP = O_YS + (size_t)MS * DM, O_KVS = O_KVP + (size_t)2 * MP * 512,
                 O_WINP = O_KVS + (size_t)2 * MS * 512, O_WINS = O_WINP + (size_t)2 * 2 * 512 * 256, O_SREP = O_WINS + (size_t)2 * 32 * 512 * 256,
                 O_SIMP = O_SREP + 2 * 2 * 2048, O_SRES = O_SIMP + 2 * 2 * 2048, O_SIMS = O_SRES + 2 * 32 * 2048, O_CONVP = O_SIMS + 2 * 32 * 2048,
                 O_CONVS = O_CONVP + 2 * 2 * 2 * 512, O_POOLP = O_CONVS + 2 * 32 * 2 * 512, O_POOLS = O_POOLP + 2 * 2 * 15 * 512, O_END = O_POOLS + 2 * 32 * 15 * 512;
static_assert(O_END == 35342336, "output size");
constexpr size_t MiB = 1u << 20;
constexpr size_t WS_CTL = 0, CTL_ZERO_BYTES = 1 * MiB;
constexpr size_t WS_WIN = 2 * MiB;
constexpr size_t WS_WOUT = WS_WIN + 32 * MiB;
constexpr size_t WS_WUP = WS_WOUT + 16 * MiB;
constexpr size_t WS_WDN = WS_WUP + 64 * MiB;
constexpr size_t WS_XB = WS_WDN + 64 * MiB;
constexpr size_t WS_XF = WS_XB + 34 * MiB;
constexpr size_t WS_H = WS_XF + 66 * MiB;
constexpr size_t WS_YC = WS_H + 68 * MiB;
constexpr size_t WS_PRE = WS_YC + 34 * MiB;
constexpr size_t WS_X1F = WS_PRE + 66 * MiB;
constexpr size_t WS_X1B = WS_X1F + 66 * MiB;
constexpr size_t WS_HF = WS_X1B + 34 * MiB;
constexpr size_t WS_KCS = WS_HF + 134 * MiB;
constexpr size_t WS_KCP = WS_KCS + 8 * MiB;
constexpr size_t WS_SEL = WS_KCP + 1 * MiB;
constexpr size_t WS_OC = WS_SEL + 1 * MiB;
constexpr size_t WS_OS = WS_OC + 18 * MiB;
constexpr size_t WS_OW = WS_OS + 18 * MiB;
constexpr size_t WS_YA = WS_OW + 18 * MiB;
constexpr size_t WS_PL = WS_YA + 18 * MiB;
constexpr size_t WS_HS = WS_PL + 18 * MiB;
constexpr size_t WS_END = WS_HS + 132 * MiB;

typedef unsigned short bf16_t;
__host__ __device__ __forceinline__ float bf2f(bf16_t v) { union { unsigned u; float f; } x; x.u = (unsigned)v << 16; return x.f; }
__host__ __device__ __forceinline__ bf16_t f2bf(float f) { union { unsigned u; float f; } x; x.f = f; unsigned u = x.u; return (bf16_t)((u + 0x7fffu + ((u >> 16) & 1u)) >> 16); }

namespace pg8 {
#define PG8_LAS __attribute__((address_space(3)))
typedef unsigned short bf16_t;
typedef short bf16x8 __attribute__((ext_vector_type(8)));
typedef float f32x4 __attribute__((ext_vector_type(4)));
typedef unsigned u32x4 __attribute__((ext_vector_type(4)));
constexpr int BM = 256, BK = 64, HALF = 128, HTB = HALF * BK * 2  , STAGE_BYTES = 8 * HTB, NXCD = 8, WGM = 8;

__host__ __device__ __forceinline__ int lds_byte(int r, int c) { const int st = (r >> 4) * 2 + (c >> 5), rr = r & 15, cc = c & 31, ob = rr * 64 + cc * 2; return st * 1024 + (ob ^ (((ob >> 9) & 1) << 5)); }
__host__ __device__ __forceinline__ void stage_rc(int b, int& R, int& C) { const int st = b / 1024, sb = b % 1024, swz = sb ^ (((sb >> 9) & 1) << 5); R = (st >> 1) * 16 + swz / 64; C = (st & 1) * 32 + (swz % 64) / 2; }
__host__ __device__ __forceinline__ int perm32(int rho) { const int n = rho >> 4, i = rho & 15; return 8 * (i >> 2) + 4 * n + (i & 3); }

struct Unit { int pm, pn; };
struct Gemm { const bf16_t* A; const bf16_t* Bt; int M, N, K; };

struct StaticOrder {
    int nM, nN, nwg, G, c;
    __host__ __device__ void init(int M, int N, int G_, int c_) { nM = M / BM; nN = N / BM; nwg = nM * nN; G = G_; c = c_; }
    __host__ __device__ bool next(int i, Unit& u) const {
        const long L = (long)i * G + c; if (L >= nwg) return false;
        int wgid = (int)L; { const int q = nwg / NXCD, r = nwg % NXCD, xcd = wgid % NXCD, off = wgid / NXCD; wgid = (xcd < r ? xcd * (q + 1) : r * (q + 1) + (xcd - r) * q) + off; }
        const int nig = WGM * nN, gid = wgid / nig, fm = gid * WGM, gsz = (nM - fm) < WGM ? (nM - fm) : WGM;
        u.pm = fm + ((wgid % nig) % gsz); u.pn = (wgid % nig) / gsz; return true;
    }
    __device__ __forceinline__ void a_ready(const Unit&) const {}
    __device__ __forceinline__ void done(const Unit&) const {}
};

__device__ __forceinline__ unsigned cvt_pk_bf16(float lo, float hi) { unsigned r; asm volatile("v_cvt_pk_bf16_f32 %0, %1, %2" : "=v"(r) : "v"(lo), "v"(hi)); return r; }
typedef float f32x2 __attribute__((ext_vector_type(2)));
struct EpiIn {
    static constexpr bool PERM = true, AFTER_DRAIN = false;
    bf16_t* H; float* okv; float* owin;
    __device__ __forceinline__ void operator()(const f32x4 (&acc)[2][2][4][2], const Unit& u, int wr, int wc, int fr, int fq) const {
        const int row0 = u.pm * BM + wr * 64 + fr, col0 = u.pn * BM + wc * 32 + 8 * fq;
#pragma unroll
        for (int ai = 0; ai < 2; ++ai)
#pragma unroll
            for (int m = 0; m < 4; ++m) { const int row = row0 + ai * HALF + m * 16;
#pragma unroll
                for (int bj = 0; bj < 2; ++bj) { const f32x4 v0 = acc[ai][bj][m][0], v1 = acc[ai][bj][m][1]; const int col = col0 + bj * HALF;
                    u32x4 w; w.x = cvt_pk_bf16(v0[0], v0[1]); w.y = cvt_pk_bf16(v0[2], v0[3]); w.z = cvt_pk_bf16(v1[0], v1[1]); w.w = cvt_pk_bf16(v1[2], v1[3]);
                    *(u32x4*)(H + (size_t)row * 4096 + col) = w;
                    if (u.pn == 12 || u.pn == 13) { float* p = okv + (size_t)row * 512 + (col - 3072); *(f32x4*)p = v0; *(f32x4*)(p + 4) = v1; }
                    if (u.pn == 14) { const int t = row & 4095, b = row >> 12; if (t >= 3584) { float* p = owin + ((size_t)(b * 512 + t - 3584) * 256 + (col - 3584)); *(f32x4*)p = v0; *(f32x4*)(p + 4) = v1; } }
                } }
    }
};
struct EpiRes {
    static constexpr bool PERM = true, AFTER_DRAIN = false;
    const float* res; float* pre; float alpha;
    __device__ __forceinline__ void operator()(const f32x4 (&acc)[2][2][4][2], const Unit& u, int wr, int wc, int fr, int fq) const {
        const int row0 = u.pm * BM + wr * 64 + fr, col0 = u.pn * BM + wc * 32 + 8 * fq;
#pragma unroll
        for (int ai = 0; ai < 2; ++ai)
#pragma unroll
            for (int m = 0; m < 4; ++m) { const int row = row0 + ai * HALF + m * 16;
#pragma unroll
                for (int bj = 0; bj < 2; ++bj) { const size_t off = (size_t)row * 2048 + col0 + bj * HALF;
                    const f32x4 r0 = *(const f32x4*)(res + off), r1 = *(const f32x4*)(res + off + 4);
                    *(f32x4*)(pre + off) = r0 * alpha + acc[ai][bj][m][0]; *(f32x4*)(pre + off + 4) = r1 * alpha + acc[ai][bj][m][1]; } }
    }
};
struct EpiRelu2 {
    static constexpr bool PERM = true, AFTER_DRAIN = false;
    bf16_t* O;
    __device__ __forceinline__ void operator()(const f32x4 (&acc)[2][2][4][2], const Unit& u, int wr, int wc, int fr, int fq) const {
        const int row0 = u.pm * BM + wr * 64 + fr, col0 = u.pn * BM + wc * 32 + 8 * fq;
#pragma unroll
        for (int ai = 0; ai < 2; ++ai)
#pragma unroll
            for (int m = 0; m < 4; ++m) { const int row = row0 + ai * HALF + m * 16;
#pragma unroll
                for (int bj = 0; bj < 2; ++bj) { f32x4 v0 = acc[ai][bj][m][0], v1 = acc[ai][bj][m][1];
#pragma unroll
                    for (int e = 0; e < 4; ++e) { const float a = fmaxf(v0[e], 0.f), b = fmaxf(v1[e], 0.f); v0[e] = a * a; v1[e] = b * b; }
                    u32x4 w; w.x = cvt_pk_bf16(v0[0], v0[1]); w.y = cvt_pk_bf16(v0[2], v0[3]); w.z = cvt_pk_bf16(v1[0], v1[1]); w.w = cvt_pk_bf16(v1[2], v1[3]);
                    *(u32x4*)(O + (size_t)row * 8192 + col0 + bj * HALF) = w; } }
    }
};
template <class Epi, class Sched, bool ALIGN_EPI = false, bool SP2 = false>
__device__ __forceinline__ void gemm_phase(PG8_LAS unsigned char* lds, const Gemm g, const Sched& S, const Epi& E) {
    const int tid = threadIdx.x, wid = __builtin_amdgcn_readfirstlane(tid >> 6), lane = tid & 63, wr = wid >> 2, wc = wid & 3, fr = lane & 15, fq = lane >> 4;
    const int K = g.K, nt = K / BK;
    unsigned voffA[2], voffB[2];
#pragma unroll
    for (int i = 0; i < 2; ++i) { int R, C; stage_rc(tid * 16 + i * 8192, R, C); const int Rb = Epi::PERM ? ((R & ~31) + perm32(R & 31)) : R;
        voffA[i] = (unsigned)(R * K + C) * 2u; voffB[i] = (unsigned)(Rb * K + C) * 2u; }
    const size_t kstep = (size_t)(BK * 2);
    const size_t hstep = (size_t)HALF * K * 2;
    const size_t tstep = 2 * hstep;
    const unsigned ldsw = (unsigned)wid * 1024u;
    const int aoff = lds_byte(wr * 64 + fr, fq * 8), boff = lds_byte(wc * 32 + fr, fq * 8);
#define PG8_SA(b, h) (((b) * 2 + (h)) * HTB)
#define PG8_SB(b, h) ((4 + (b) * 2 + (h)) * HTB)
#define PG8_STAGE(bufoff, gbase, voff) do { _Pragma("unroll") for (int _i = 0; _i < 2; ++_i) \
        __builtin_amdgcn_global_load_lds((const unsigned*)((const char*)(gbase) + (voff)[_i]), (PG8_LAS unsigned*)(lds + (bufoff) + ldsw + _i * 8192), 16, 0, 0); } while (0)
#define PG8_LDA(dst, b, h) do { _Pragma("unroll") for (int m = 0; m < 4; ++m) _Pragma("unroll") for (int k = 0; k < 2; ++k) dst[m][k] = *(const PG8_LAS bf16x8*)(lds + PG8_SA(b, h) + aoff + m * 2048 + k * 1024); } while (0)
#define PG8_LDB(dst, b, h) do { _Pragma("unroll") for (int n = 0; n < 2; ++n) _Pragma("unroll") for (int k = 0; k < 2; ++k) dst[n][k] = *(const PG8_LAS bf16x8*)(lds + PG8_SB(b, h) + boff + n * 2048 + k * 1024); } while (0)
#define PG8_MMA(ai, bj, At, Bt) do { __builtin_amdgcn_s_setprio(1); _Pragma("unroll") for (int m = 0; m < 4; ++m) _Pragma("unroll") for (int n = 0; n < 2; ++n) _Pragma("unroll") for (int k = 0; k < 2; ++k) \
        acc[ai][bj][m][n] = __builtin_amdgcn_mfma_f32_16x16x32_bf16(Bt[n][k], At[m][k], acc[ai][bj][m][n], 0, 0, 0); __builtin_amdgcn_s_setprio(0); } while (0)
#define PG8_WAIT_V(n) asm volatile("s_waitcnt vmcnt(" #n ")" ::: "memory")
#define PG8_WAIT_L(n) asm volatile("s_waitcnt lgkmcnt(" #n ")" ::: "memory")
#define PG8_BAR __builtin_amdgcn_s_barrier()
#define PG8_SCHED __builtin_amdgcn_sched_barrier(0)
    Unit cur, nxt; int ui = 0;
    if (!S.next(0, cur)) return;
    f32x4 acc[2][2][4][2];
#pragma unroll
    for (int a = 0; a < 2; ++a)
#pragma unroll
        for (int b = 0; b < 2; ++b)
#pragma unroll
            for (int m = 0; m < 4; ++m)
#pragma unroll
                for (int n = 0; n < 2; ++n) acc[a][b][m][n] = (f32x4){0.f, 0.f, 0.f, 0.f};
    bf16x8 At[4][2], B0[2][2], B1[2][2];
    const char* cA = (const char*)g.A + (size_t)cur.pm * tstep; const char* cB = (const char*)g.Bt + (size_t)cur.pn * tstep;
    S.a_ready(cur);
    if constexpr (SP2) {
        PG8_STAGE(PG8_SB(0, 0), cB, voffB); PG8_STAGE(PG8_SB(0, 1), cB + hstep, voffB); PG8_STAGE(PG8_SA(0, 0), cA, voffA); PG8_STAGE(PG8_SA(0, 1), cA + hstep, voffA);
        if (wr == 1) PG8_BAR;
        PG8_WAIT_V(2); PG8_BAR;
        PG8_STAGE(PG8_SB(1, 0), cB + kstep, voffB); PG8_STAGE(PG8_SA(1, 0), cA + kstep, voffA); PG8_STAGE(PG8_SB(1, 1), cB + hstep + kstep, voffB);
        PG8_WAIT_V(6); PG8_BAR;
    } else {
        PG8_STAGE(PG8_SB(0, 0), cB, voffB); PG8_STAGE(PG8_SA(0, 0), cA, voffA); PG8_STAGE(PG8_SB(0, 1), cB + hstep, voffB); PG8_STAGE(PG8_SA(0, 1), cA + hstep, voffA);
        if (wr == 1) PG8_BAR;
        PG8_WAIT_V(4); PG8_BAR;
        PG8_STAGE(PG8_SB(1, 0), cB + kstep, voffB); PG8_STAGE(PG8_SA(1, 0), cA + kstep, voffA); PG8_STAGE(PG8_SB(1, 1), cB + hstep + kstep, voffB);
        PG8_WAIT_V(6); PG8_BAR;
    }
    for (;;) {
        const bool has_next = S.next(ui + 1, nxt);
        const char* nA = has_next ? (const char*)g.A + (size_t)nxt.pm * tstep : cA; const char* nB = has_next ? (const char*)g.Bt + (size_t)nxt.pn * tstep : cB;
        for (int t = 0; t < nt; t += 2) {
            const bool last = (t == nt - 2);
            const char* a1 = cA + (size_t)(t + 1) * kstep;
            const char* a2 = last ? nA : cA + (size_t)(t + 2) * kstep; const char* b2 = last ? nB : cB + (size_t)(t + 2) * kstep;
            const char* a3 = a2 + kstep; const char* b3 = b2 + kstep;
            if (last && has_next) S.a_ready(nxt);
            if constexpr (SP2) {
            PG8_LDB(B0, 0, 0); PG8_LDB(B1, 0, 1); PG8_SCHED; PG8_LDA(At, 0, 0); PG8_STAGE(PG8_SA(1, 1), a1 + hstep, voffA);
            PG8_WAIT_V(8); PG8_WAIT_L(0); PG8_BAR; PG8_MMA(0, 0, At, B0); PG8_MMA(0, 1, At, B1); PG8_BAR; PG8_SCHED;
            PG8_LDA(At, 0, 1); PG8_STAGE(PG8_SB(0, 0), b2, voffB); PG8_STAGE(PG8_SB(0, 1), b2 + hstep, voffB); PG8_STAGE(PG8_SA(0, 0), a2, voffA);
            PG8_WAIT_V(8); PG8_WAIT_L(0); PG8_BAR; PG8_MMA(1, 0, At, B0); PG8_MMA(1, 1, At, B1); PG8_BAR; PG8_SCHED;
            PG8_LDB(B0, 1, 0); PG8_LDB(B1, 1, 1); PG8_SCHED; PG8_LDA(At, 1, 0); PG8_STAGE(PG8_SA(0, 1), a2 + hstep, voffA);
            PG8_WAIT_V(8); PG8_WAIT_L(0); PG8_BAR; PG8_MMA(0, 0, At, B0); PG8_MMA(0, 1, At, B1); PG8_BAR; PG8_SCHED;
            PG8_LDA(At, 1, 1); PG8_STAGE(PG8_SB(1, 0), b3, voffB); PG8_STAGE(PG8_SB(1, 1), b3 + hstep, voffB); PG8_STAGE(PG8_SA(1, 0), a3, voffA);
            PG8_WAIT_V(8); PG8_WAIT_L(0); PG8_BAR; PG8_MMA(1, 0, At, B0); PG8_MMA(1, 1, At, B1); PG8_BAR; PG8_SCHED;
            } else {
            PG8_LDB(B0, 0, 0); PG8_SCHED; PG8_LDA(At, 0, 0); PG8_STAGE(PG8_SA(1, 1), a1 + hstep, voffA);
            PG8_WAIT_L(8); PG8_BAR; PG8_WAIT_L(0); PG8_MMA(0, 0, At, B0); PG8_BAR; PG8_SCHED;
            PG8_LDB(B1, 0, 1); PG8_STAGE(PG8_SB(0, 0), b2, voffB);
            PG8_BAR; PG8_WAIT_L(0); PG8_MMA(0, 1, At, B1); PG8_BAR;
            PG8_LDA(At, 0, 1); PG8_STAGE(PG8_SA(0, 0), a2, voffA);
            PG8_BAR; PG8_WAIT_L(0); PG8_MMA(1, 0, At, B0); PG8_BAR; PG8_SCHED;
            PG8_STAGE(PG8_SB(0, 1), b2 + hstep, voffB);
            PG8_WAIT_V(6); PG8_BAR; PG8_MMA(1, 1, At, B1); PG8_BAR;
            PG8_LDB(B0, 1, 0); PG8_SCHED; PG8_LDA(At, 1, 0); PG8_STAGE(PG8_SA(0, 1), a2 + hstep, voffA);
            PG8_WAIT_L(8); PG8_BAR; PG8_WAIT_L(0); PG8_MMA(0, 0, At, B0); PG8_BAR; PG8_SCHED;
            PG8_LDB(B1, 1, 1); PG8_STAGE(PG8_SB(1, 0), b3, voffB);
            PG8_BAR; PG8_WAIT_L(0); PG8_MMA(0, 1, At, B1); PG8_BAR;
            PG8_LDA(At, 1, 1); PG8_STAGE(PG8_SA(1, 0), a3, voffA);
            PG8_BAR; PG8_WAIT_L(0); PG8_MMA(1, 0, At, B0); PG8_BAR; PG8_SCHED;
            PG8_STAGE(PG8_SB(1, 1), b3 + hstep, voffB);
            PG8_WAIT_V(6); PG8_BAR; PG8_MMA(1, 1, At, B1); PG8_BAR;
            }
        }
        if constexpr (ALIGN_EPI) { if (wr == 0) PG8_BAR; }
        if constexpr (!Epi::AFTER_DRAIN) { E(acc, cur, wr, wc, fr, fq); S.done(cur); }
        if (!has_next) break;
#pragma unroll
        for (int a = 0; a < 2; ++a)
#pragma unroll
            for (int b = 0; b < 2; ++b)
#pragma unroll
                for (int m = 0; m < 4; ++m)
#pragma unroll
                    for (int n = 0; n < 2; ++n) acc[a][b][m][n] = (f32x4){0.f, 0.f, 0.f, 0.f};
        cur = nxt; cA = nA; cB = nB; ++ui;
        if constexpr (ALIGN_EPI) { if (wr == 1) PG8_BAR; }
    }
    PG8_WAIT_V(0);
    if constexpr (!ALIGN_EPI) { if (wr == 0) PG8_BAR; }
    PG8_BAR;
    if constexpr (Epi::AFTER_DRAIN) { E.fused(acc, cur, wr, wc, fr, fq, lds, wid, lane); S.done(cur); }
#undef PG8_SA
#undef PG8_SB
#undef PG8_STAGE
#undef PG8_LDA
#undef PG8_LDB
#undef PG8_MMA
#undef PG8_WAIT_V
#undef PG8_WAIT_L
#undef PG8_BAR
#undef PG8_SCHED
}
}
typedef float f32x4 __attribute__((ext_vector_type(4)));
typedef short bf16x8 __attribute__((ext_vector_type(8)));
typedef unsigned u32x4 __attribute__((ext_vector_type(4)));
typedef unsigned u32x2 __attribute__((ext_vector_type(2)));

__device__ __forceinline__ float wave_sum(float v) {
#pragma unroll
    for (int o = 1; o < 64; o <<= 1) v += __shfl_xor(v, o);
    return v;
}
__device__ __forceinline__ float wave_max(float v) {
#pragma unroll
    for (int o = 1; o < 64; o <<= 1) v = fmaxf(v, __shfl_xor(v, o));
    return v;
}

__global__ void k_transpose_bf16(const float* __restrict__ W, int K, int N, bf16_t* __restrict__ WT) {
    __shared__ float tile[32][33];
    const int n0 = blockIdx.x * 32, k0 = blockIdx.y * 32;
    for (int i = threadIdx.y; i < 32; i += 8) { const int n = n0 + threadIdx.x; tile[i][threadIdx.x] = (n < N) ? W[(size_t)(k0 + i) * N + n] : 0.f; }
    __syncthreads();
    for (int i = threadIdx.y; i < 32; i += 8) WT[(size_t)(n0 + i) * K + k0 + threadIdx.x] = f2bf(tile[threadIdx.x][i]);
}
__global__ void k_x2bf(const float* __restrict__ xp, const float* __restrict__ xs, bf16_t* __restrict__ XB) {
    const size_t i = ((size_t)blockIdx.x * blockDim.x + threadIdx.x) * 4;
    if (i >= (size_t)MT * DM) return;
    const float* src = (i < (size_t)MP * DM) ? xp + i : xs + (i - (size_t)MP * DM);
    const f32x4 v = *(const f32x4*)src;
    u32x2 w; w.x = (unsigned)f2bf(v[0]) | ((unsigned)f2bf(v[1]) << 16); w.y = (unsigned)f2bf(v[2]) | ((unsigned)f2bf(v[3]) << 16);
    *(u32x2*)(XB + i) = w;
}

template <int MODE>
__global__ void __launch_bounds__(256) k_sgemm(const bf16_t* __restrict__ A, int lda, const bf16_t* __restrict__ Wt, int N, int K,
                                                bf16_t* __restrict__ OB, float* __restrict__ OF, const float* __restrict__ res, float* __restrict__ okv, float* __restrict__ owin) {
    const int wave = (blockIdx.x * 256 + threadIdx.x) >> 6, lane = threadIdx.x & 63;
    const int ntn = N / 16, mt = wave / ntn, nt = wave % ntn;
    if (mt >= 8) return;
    const int fr = lane & 15, fq = lane >> 4;
    const bf16_t* ap = A + (size_t)(mt * 16 + fr) * lda + fq * 8;
    const bf16_t* wp = Wt + (size_t)(nt * 16 + fr) * K + fq * 8;
    f32x4 acc = {0.f, 0.f, 0.f, 0.f};
#pragma unroll 4
    for (int k = 0; k < K; k += 32) {
        const bf16x8 a = *(const bf16x8*)(ap + k), w = *(const bf16x8*)(wp + k);
        acc = __builtin_amdgcn_mfma_f32_16x16x32_bf16(w, a, acc, 0, 0, 0);
    }
    const int m = mt * 16 + fr, n = nt * 16 + fq * 4;
    if (MODE == 0) {
        if (n < NIN) {
            u32x2 w; w.x = (unsigned)f2bf(acc[0]) | ((unsigned)f2bf(acc[1]) << 16); w.y = (unsigned)f2bf(acc[2]) | ((unsigned)f2bf(acc[3]) << 16);
            *(u32x2*)(OB + (size_t)(MP + m) * 4096 + n) = w;
            if (n >= 3072 && n < 3584) *(f32x4*)(okv + (size_t)m * 512 + (n - 3072)) = acc;
            if (n >= 3584 && n < 3840) { const int bs = m >> 2, ts = m & 3; *(f32x4*)(owin + ((size_t)(bs * 512 + 508 + ts) * 256 + (n - 3584))) = acc; }
        }
    } else if (MODE == 1) {
        const size_t off = (size_t)m * 2048 + n; const f32x4 r = *(const f32x4*)(res + off);
        *(f32x4*)(OF + off) = r * ALPHA + acc;
    } else {
        f32x4 v = acc;
#pragma unroll
        for (int e = 0; e < 4; ++e) { const float a = fmaxf(v[e], 0.f); v[e] = a * a; }
        u32x2 w; w.x = (unsigned)f2bf(v[0]) | ((unsigned)f2bf(v[1]) << 16); w.y = (unsigned)f2bf(v[2]) | ((unsigned)f2bf(v[3]) << 16);
        *(u32x2*)(OB + (size_t)(MP + m) * 8192 + n) = w;
    }
}

struct SsmP { const float *a_re, *a_im, *b_re, *b_im, *c_re, *c_im, *d, *log_dt, *w_glu, *b_glu; };
__global__ void k_ssm_scan(SsmP P, const bf16_t* __restrict__ H, const float* __restrict__ s_re, const float* __restrict__ s_im,
                           float* __restrict__ HS, float* __restrict__ o_rep, float* __restrict__ o_imp, float* __restrict__ o_res, float* __restrict__ o_ims) {
    const int id = blockIdx.x * blockDim.x + threadIdx.x;
    if (id >= 34 * 2048) return;
    const int s = id / 2048, gn = id % 2048, g = gn / 64;
    const float dt = expf(P.log_dt[g]), are = P.a_re[gn], aim = P.a_im[gn];
    const float mag = expf(dt * are), abr = mag * cosf(dt * aim), abi = mag * sinf(dt * aim);
    const float den = are * are + aim * aim, nr = abr - 1.0f;
    const float fre = (nr * are + abi * aim) / den, fim = (abi * are - nr * aim) / den;
    float bbr[16], bbi[16];
#pragma unroll
    for (int c = 0; c < 16; ++c) { const float br = P.b_re[gn * 16 + c], bi = P.b_im[gn * 16 + c]; bbr[c] = fre * br - fim * bi; bbi[c] = fre * bi + fim * br; }
    float hr = 0.f, hi = 0.f; int T = TP, m0 = s * TP;
    if (s >= 2) { const int bs = s - 2; T = STOK; m0 = MP + bs * STOK; hr = s_re[bs * 2048 + gn]; hi = s_im[bs * 2048 + gn]; }
    for (int t = 0; t < T; ++t) {
        const bf16_t* up = H + (size_t)(m0 + t) * 4096 + C_USSM + g * 16;
        const u32x4 w0 = *(const u32x4*)up, w1 = *(const u32x4*)(up + 8);
        float u[16];
#pragma unroll
        for (int e = 0; e < 4; ++e) { u[2 * e] = __uint_as_float(w0[e] << 16); u[2 * e + 1] = __uint_as_float(w0[e] & 0xffff0000u); u[8 + 2 * e] = __uint_as_float(w1[e] << 16); u[8 + 2 * e + 1] = __uint_as_float(w1[e] & 0xffff0000u); }
        float bur = 0.f, bui = 0.f;
#pragma unroll
        for (int c = 0; c < 16; ++c) { bur += bbr[c] * u[c]; bui += bbi[c] * u[c]; }
        const float nhr = abr * hr - abi * hi + bur, nhi = abr * hi + abi * hr + bui;
        hr = nhr; hi = nhi;
        float* hp = HS + ((size_t)(m0 + t) * 2048 + gn) * 2; hp[0] = hr; hp[1] = hi;
    }
    if (s < 2) { o_rep[s * 2048 + gn] = hr; o_imp[s * 2048 + gn] = hi; } else { o_res[(s - 2) * 2048 + gn] = hr; o_ims[(s - 2) * 2048 + gn] = hi; }
}
__device__ __forceinline__ float gelu_tanh(float x) { const float u = 0.7978845608028654f * (x + 0.044715f * x * x * x); return 0.5f * x * (1.0f + tanhf(u)); }
__global__ void k_ssm_y(SsmP P, const bf16_t* __restrict__ H, const float* __restrict__ HS, float* __restrict__ YA) {
    const int id = blockIdx.x * blockDim.x + threadIdx.x;
    if (id >= MT * 512) return;
    const int m = id / 512, ch = id % 512, g = ch / 16;
    const float* hp = HS + ((size_t)m * 2048 + g * 64) * 2; const float* cr = P.c_re + ch * 64; const float* ci = P.c_im + ch * 64;
    float y = 0.f;
    for (int n = 0; n < 64; ++n) y += cr[n] * hp[2 * n] - ci[n] * hp[2 * n + 1];
    y += P.d[ch] * bf2f(H[(size_t)m * 4096 + C_USSM + ch]);
    YA[id] = gelu_tanh(y);
}
__global__ void k_ssm_glu(SsmP P, const float* __restrict__ YA, bf16_t* __restrict__ YC) {
    const int id = blockIdx.x * blockDim.x + threadIdx.x;
    if (id >= MT * 512) return;
    const int m = id / 512, j = id % 512;
    const float* yr = YA + (size_t)m * 512; float z = P.b_glu[j];
    for (int k = 0; k < 512; ++k) z += yr[k] * P.w_glu[k * 512 + j];
    YC[(size_t)m * 2048 + j] = f2bf(yr[j] * (1.0f / (1.0f + expf(-z))));
}

struct CpP { const float *conv_w, *conv_b, *pool_w, *pool_scale, *st_conv, *st_pool; };
__global__ void k_convpool1(CpP P, const bf16_t* __restrict__ H, bf16_t* __restrict__ YC, float* __restrict__ PL,
                            float* __restrict__ o_convp, float* __restrict__ o_convs, float* __restrict__ o_poolp, float* __restrict__ o_pools) {
    const int id = blockIdx.x * blockDim.x + threadIdx.x;
    if (id >= MT * 512) return;
    const int m = id / 512, ch = id % 512;
    const bool smp = m >= MP; const int b = smp ? (m - MP) >> 2 : m >> 12, t = smp ? (m - MP) & 3 : m & 4095, T = smp ? STOK : TP, m0 = m - t;
    float e[3];
#pragma unroll
    for (int j = 0; j < 3; ++j) { const int tt = t - 2 + j;
        if (tt >= 0) { const bf16_t* r = H + (size_t)(m0 + tt) * 4096; e[j] = bf2f(r[C_GC + ch]) * bf2f(r[C_VC + ch]); }
        else e[j] = smp ? P.st_conv[(b * 2 + (2 + tt)) * 512 + ch] : 0.f; }
    const float conv = P.conv_b[ch] + P.conv_w[ch] * e[0] + P.conv_w[512 + ch] * e[1] + P.conv_w[1024 + ch] * e[2];
    YC[(size_t)m * 2048 + 512 + ch] = f2bf(bf2f(H[(size_t)m * 4096 + C_GB + ch]) * conv);
    if (t >= T - 2) { if (smp) o_convs[(b * 2 + (t - (T - 2))) * 512 + ch] = e[2]; else o_convp[(b * 2 + (t - (T - 2))) * 512 + ch] = e[2]; }
    const int w = 2 << (ch >> 7); float sum = 0.f;
    for (int s = t - w + 1; s <= t; ++s) { sum += (s >= 0) ? bf2f(H[(size_t)(m0 + s) * 4096 + C_UP + ch]) : (smp ? P.st_pool[(b * 15 + (15 + s)) * 512 + ch] : 0.f); }
    const float ut = bf2f(H[(size_t)m * 4096 + C_UP + ch]);
    const int cnt = min(t + 1 + (smp ? 15 : 0), w);
    PL[id] = sum / (float)cnt - ut;
    if (smp) { o_pools[(b * 15 + 11 + t) * 512 + ch] = ut; if (t == 0) { for (int i = 0; i < 11; ++i) o_pools[(b * 15 + i) * 512 + ch] = P.st_pool[(b * 15 + i + 4) * 512 + ch]; } }
    else if (t >= T - 15) o_poolp[(b * 15 + (t - (T - 15))) * 512 + ch] = ut;
}
__global__ void k_pool2(CpP P, const float* __restrict__ PL, bf16_t* __restrict__ YC) {
    const int id = blockIdx.x * blockDim.x + threadIdx.x;
    if (id >= MT * 512) return;
    const int m = id / 512, j = id % 512, gi = j >> 7, dd = j & 127;
    const float* pr = PL + (size_t)m * 512 + gi * 128; const float* w = P.pool_w + (size_t)gi * 128 * 128 + dd;
    float y = 0.f;
    for (int c = 0; c < 128; ++c) y += pr[c] * w[c * 128];
    YC[(size_t)m * 2048 + 1024 + j] = f2bf(y * P.pool_scale[j]);
}

__global__ void k_compress_prompt(const bf16_t* __restrict__ H, const float* __restrict__ wck, const float* __restrict__ wcv, float* __restrict__ KCP) {
    const int id = blockIdx.x * blockDim.x + threadIdx.x;
    if (id >= 2 * 64 * 256) return;
    const int gd = id & 127, kv = (id >> 7) & 1, j = (id >> 8) & 63, b = id >> 14, d = gd & 63;
    const float* w = kv ? wcv : wck; float s = 0.f;
    for (int k = 0; k < 64; ++k) s += bf2f(H[(size_t)(b * TP + j * 64 + k) * 4096 + C_KV + kv * 128 + gd]) * w[k * 64 + d];
    KCP[id] = s;
}
__global__ void k_compress_sample(const float* __restrict__ cache  , const int* __restrict__ pt, const float* __restrict__ wck, const float* __restrict__ wcv, float* __restrict__ KCS) {
    const int id = blockIdx.x * blockDim.x + threadIdx.x;
    if (id >= 32 * 128 * 256) return;
    const int gd = id & 127, kv = (id >> 7) & 1, j = (id >> 8) & 127, bs = id >> 15, d = gd & 63;
    const float* w = kv ? wcv : wck;
    const int page = pt[bs * NPG + (j >> 1)];
    const float* base = cache + ((size_t)page * 128 + (j & 1) * 64) * 512 + kv * 128 + gd;
    float s = 0.f;
    for (int k = 0; k < 64; ++k) s += base[(size_t)k * 512] * w[k * 64 + d];
    KCS[id] = s;
}
__global__ void __launch_bounds__(256) k_cmp_topk(const bf16_t* __restrict__ H, const float* __restrict__ KCP, const float* __restrict__ KCS,
                                                   float* __restrict__ OC, unsigned long long* __restrict__ SEL) {
    const int wv = (blockIdx.x * 256 + threadIdx.x) >> 6, lane = threadIdx.x & 63;
    if (wv >= MT * 2) return;
    const int m = wv >> 1, g = wv & 1;
    const bool smp = m >= MP; const int b = smp ? (m - MP) >> 2 : m >> 12, t = smp ? (m - MP) & 3 : m & 4095;
    const int pos = smp ? PAST + t : t, cur = pos >> 6;
    const float* kc0; const float* kc1; bool ex1 = smp;
    if (smp) { kc0 = KCS + ((size_t)(b * 128 + lane) * 2) * 128 + g * 64; kc1 = KCS + ((size_t)(b * 128 + lane + 64) * 2) * 128 + g * 64; }
    else { kc0 = KCP + ((size_t)(b * 64 + lane) * 2) * 128 + g * 64; kc1 = kc0; }
    const bool cp0 = (64 * lane + 63 <= pos), cp1 = ex1 && (64 * (lane + 64) + 63 <= pos);
    float imp0 = 0.f, imp1 = 0.f;
    for (int r = 0; r < 4; ++r) {
        const bf16_t* q = H + (size_t)m * 4096 + C_Q + (g * 4 + r) * 64;
        float s0 = 0.f, s1 = 0.f;
        for (int d = 0; d < 64; ++d) { const float qv = bf2f(q[d]); s0 += qv * kc0[d]; s1 += qv * kc1[d]; }
        s0 = cp0 ? s0 * 0.125f : NEGF; s1 = cp1 ? s1 * 0.125f : NEGF;
        const float mx = wave_max(fmaxf(s0, s1));
        const float e0 = cp0 ? expf(s0 - mx) : 0.f, e1 = cp1 ? expf(s1 - mx) : 0.f;
        const float sum = wave_sum(e0 + e1), inv = sum > 0.f ? 1.0f / sum : 0.f;
        const float p0 = e0 * inv, p1 = e1 * inv;
        imp0 += p0; imp1 += p1;
        float o = 0.f;
        for (int d = 0; d < 64; ++d) { const float v = wave_sum(p0 * kc0[128 + d] + (ex1 ? p1 * kc1[128 + d] : 0.f)); if (lane == d) o = v; }
        OC[(size_t)m * 512 + (g * 4 + r) * 64 + lane] = o;
    }
    const int j0 = lane, j1 = lane + 64;
    const float sc0 = (j0 == 0 || j0 == cur || j0 == cur - 1) ? 5.0f : ((64 * j0 <= pos) ? imp0 : -1.0f);
    const float sc1 = (j1 == 0 || j1 == cur || j1 == cur - 1) ? 5.0f : ((64 * j1 <= pos) ? imp1 : -1.0f);
    int rk0 = 0, rk1 = 0;
    for (int jp = 0; jp < 64; ++jp) {
        const float a = __shfl(sc0, jp);
        rk0 += (a > sc0 || (a == sc0 && jp < j0)) ? 1 : 0;
        if (smp) { rk1 += (a > sc1 || (a == sc1 && jp < j1)) ? 1 : 0;
            const float c = __shfl(sc1, jp); const int jq = jp + 64;
            rk0 += (c > sc0 || (c == sc0 && jq < j0)) ? 1 : 0; rk1 += (c > sc1 || (c == sc1 && jq < j1)) ? 1 : 0; }
    }
    if (smp) { rk0 += (5.0f > sc0) ? 1 : 0; rk1 += (5.0f > sc1) ? 1 : 0; }
    const unsigned long long m0 = __ballot(rk0 < 16), m1 = smp ? __ballot(rk1 < 16) : 0ull;
    if (lane == 0) { unsigned long long* sp = SEL + (size_t)wv * 3; sp[0] = m0; sp[1] = m1; sp[2] = smp ? 1ull : 0ull; }
}
struct AttP { const bf16_t* H; const float* cache; const float* wcache; const int* pt; };
__device__ __forceinline__ float kv_elem(const AttP& A, bool smp, int b, int g, int slot, int kp, int d) {
    if (!smp) return bf2f(A.H[(size_t)(b * TP + kp) * 4096 + C_KV + slot * 128 + g * 64 + d]);
    if (kp >= PAST) return bf2f(A.H[(size_t)(MP + b * STOK + (kp - PAST)) * 4096 + C_KV + slot * 128 + g * 64 + d]);
    if (slot < 4) { const int page = A.pt[b * NPG + (kp >> 7)]; return A.cache[((size_t)page * 128 + (kp & 127)) * 512 + slot * 128 + g * 64 + d]; }
    return A.wcache[((size_t)b * 512 + (kp - (PAST - 512))) * 256 + (slot - 4) * 128 + g * 64 + d];
}
template <int BR>
__global__ void __launch_bounds__(256) k_attn_naive(AttP A, const unsigned long long* __restrict__ SEL, float* __restrict__ O) {
    const int wv = (blockIdx.x * 256 + threadIdx.x) >> 6, lane = threadIdx.x & 63;
    if (wv >= MT * 8) return;
    const int m = wv >> 3, h = wv & 7, g = h >> 2;
    const bool smp = m >= MP; const int b = smp ? (m - MP) >> 2 : m >> 12, t = smp ? (m - MP) & 3 : m & 4095;
    const int pos = smp ? PAST + t : t;
    float q[64];
    { const bf16_t* qp = A.H + (size_t)m * 4096 + C_Q + h * 64;
#pragma unroll
      for (int d = 0; d < 64; ++d) q[d] = bf2f(qp[d]); }
    unsigned long long mk0 = 0, mk1 = 0, mk2 = 0;
    if (BR == 0) { const unsigned long long* sp = SEL + (size_t)(m * 2 + g) * 3; mk0 = sp[0]; mk1 = sp[1]; mk2 = sp[2]; }
    float mrun = NEGF, l = 0.f, o = 0.f;
    const int nchunk = BR == 0 ? 16 : 8;
    for (int c = 0; c < nchunk; ++c) {
        int kp0;
        if (BR == 0) { int kb; if (mk0) { kb = __builtin_ctzll(mk0); mk0 &= mk0 - 1; } else if (mk1) { kb = 64 + __builtin_ctzll(mk1); mk1 &= mk1 - 1; } else if (mk2) { kb = 128; mk2 = 0; } else break; kp0 = kb * 64; }
        else kp0 = pos - 511 + 64 * c;
        const int kp = kp0 + lane;
        const bool valid = (kp >= 0) && (kp <= pos);
        float s = NEGF;
        if (valid) { float a = 0.f;
#pragma unroll
            for (int d = 0; d < 64; ++d) a += q[d] * kv_elem(A, smp, b, g, BR == 0 ? 2 : 4, kp, d);
            s = a * 0.125f; }
        const float bm = wave_max(s), mnew = fmaxf(mrun, bm), alpha = expf(mrun - mnew);
        const float e = valid ? expf(s - mnew) : 0.f;
        l = l * alpha + wave_sum(e); o *= alpha; mrun = mnew;
        for (int k = 0; k < 64; ++k) { const float ek = __shfl(e, k); if (ek != 0.f) o += ek * kv_elem(A, smp, b, g, BR == 0 ? 3 : 5, kp0 + k, lane); }
    }
    O[(size_t)m * 512 + h * 64 + lane] = o / l;
}
__global__ void k_combine(const bf16_t* __restrict__ H, const float* __restrict__ OC, const float* __restrict__ OS, const float* __restrict__ OW, bf16_t* __restrict__ YC) {
    const int id = blockIdx.x * blockDim.x + threadIdx.x;
    if (id >= MT * 512) return;
    const int m = id / 512, hd = id % 512, h = hd >> 6;
    const bf16_t* gp = H + (size_t)m * 4096 + C_GATE + h * 3;
    const float g0 = 1.f / (1.f + expf(-bf2f(gp[0]))), g1 = 1.f / (1.f + expf(-bf2f(gp[1]))), g2 = 1.f / (1.f + expf(-bf2f(gp[2])));
    YC[(size_t)m * 2048 + 1536 + hd] = f2bf(g0 * OC[id] + g1 * OS[id] + g2 * OW[id]);
}
__global__ void k_wincopy(const float* __restrict__ wcache, float* __restrict__ owin) {
    const size_t id = (size_t)blockIdx.x * blockDim.x + threadIdx.x;
    if (id >= (size_t)32 * 508 * 64) return;
    const int bs = (int)(id / (508 * 64)); const size_t r = id % (508 * 64);
    *(f32x4*)(owin + (size_t)bs * 512 * 256 + r * 4) = *(const f32x4*)(wcache + (size_t)bs * 512 * 256 + 4 * 256 + r * 4);
}
__global__ void __launch_bounds__(256) k_ln(const float* __restrict__ PRE, const float* __restrict__ gam, const float* __restrict__ bet,
                                             float* __restrict__ outFp, float* __restrict__ outFs, bf16_t* __restrict__ outB) {
    const int m = (blockIdx.x * 256 + threadIdx.x) >> 6, lane = threadIdx.x & 63;
    if (m >= MT) return;
    const float* pr = PRE + (size_t)m * DM;
    f32x4 v[8]; float s = 0.f;
#pragma unroll
    for (int j = 0; j < 8; ++j) { v[j] = *(const f32x4*)(pr + j * 256 + lane * 4); s += (v[j][0] + v[j][1]) + (v[j][2] + v[j][3]); }
    const float mean = wave_sum(s) * (1.0f / DM); float s2 = 0.f;
#pragma unroll
    for (int j = 0; j < 8; ++j) { v[j] = v[j] - mean; s2 += (v[j][0] * v[j][0] + v[j][1] * v[j][1]) + (v[j][2] * v[j][2] + v[j][3] * v[j][3]); }
    const float rstd = 1.0f / sqrtf(wave_sum(s2) * (1.0f / DM) + LN_EPS);
    float* of = (m < MP) ? outFp + (size_t)m * DM : outFs + (size_t)(m - MP) * DM;
#pragma unroll
    for (int j = 0; j < 8; ++j) { const int c = j * 256 + lane * 4; const f32x4 gg = *(const f32x4*)(gam + c), bb = *(const f32x4*)(bet + c);
        const f32x4 y = v[j] * rstd * gg + bb; *(f32x4*)(of + c) = y;
        if (outB) { u32x2 w; w.x = (unsigned)f2bf(y[0]) | ((unsigned)f2bf(y[1]) << 16); w.y = (unsigned)f2bf(y[2]) | ((unsigned)f2bf(y[3]) << 16); *(u32x2*)(outB + (size_t)m * DM + c) = w; } }
}
constexpr int NWAVES = 8;
constexpr int RING_OFF = 0, RING_BYTES = 131072;
constexpr int LDSCTL_OFF = RING_BYTES, MISC_OFF = LDSCTL_OFF + 320;
constexpr int LDS_BYTES = 147456;
#define LAS __attribute__((address_space(3)))

struct Args {
    const float* in[33]; float* out; unsigned char* ws; int phase, layer;
};
__global__ void __launch_bounds__(NWAVES * 64, 2) mk(Args a) {
    extern __shared__ __attribute__((aligned(16))) unsigned char lds[];
    LAS unsigned char* L = (LAS unsigned char*)lds;
    unsigned char* ws = a.ws; const int l = a.layer;
    bf16_t* XB = (bf16_t*)(ws + WS_XB); float* XF = (float*)(ws + WS_XF); bf16_t* H = (bf16_t*)(ws + WS_H); bf16_t* YC = (bf16_t*)(ws + WS_YC);
    float* PRE = (float*)(ws + WS_PRE); float* X1F = (float*)(ws + WS_X1F); bf16_t* X1B = (bf16_t*)(ws + WS_X1B); bf16_t* HF = (bf16_t*)(ws + WS_HF);
    const int G = gridDim.x;
    if (a.phase == 0) {
        pg8::Gemm g{XB, (const bf16_t*)(ws + WS_WIN) + (size_t)l * NINP * DM, MP, NINP, DM}; pg8::StaticOrder S; S.init(MP, NINP, G, (int)blockIdx.x);
        pg8::EpiIn E{H, a.out + O_KVP + (size_t)l * MP * 512, a.out + O_WINP + (size_t)l * 2 * 512 * 256};
        pg8::gemm_phase<pg8::EpiIn, pg8::StaticOrder, true, true>(L + RING_OFF, g, S, E);
    } else if (a.phase == 1) {
        pg8::Gemm g{YC, (const bf16_t*)(ws + WS_WOUT) + (size_t)l * DM * DM, MP, DM, DM}; pg8::StaticOrder S; S.init(MP, DM, G, (int)blockIdx.x);
        pg8::EpiRes E{l == 0 ? a.in[0] : XF, PRE, ALPHA};
        pg8::gemm_phase<pg8::EpiRes, pg8::StaticOrder, true, true>(L + RING_OFF, g, S, E);
    } else if (a.phase == 2) {
        pg8::Gemm g{X1B, (const bf16_t*)(ws + WS_WUP) + (size_t)l * DFF * DM, MP, DFF, DM}; pg8::StaticOrder S; S.init(MP, DFF, G, (int)blockIdx.x);
        pg8::EpiRelu2 E{HF};
        pg8::gemm_phase<pg8::EpiRelu2, pg8::StaticOrder, true, true>(L + RING_OFF, g, S, E);
    } else {
        pg8::Gemm g{HF, (const bf16_t*)(ws + WS_WDN) + (size_t)l * DM * DFF, MP, DM, DFF}; pg8::StaticOrder S; S.init(MP, DM, G, (int)blockIdx.x);
        pg8::EpiRes E{X1F, PRE, ALPHA};
        pg8::gemm_phase<pg8::EpiRes, pg8::StaticOrder, true, true>(L + RING_OFF, g, S, E);
    }
}

extern "C" void kernel_launch(void* const* d_in, const int* in_sizes, int n_in, void* d_out, int out_size, void* d_ws, size_t ws_size, hipStream_t stream) {
    static int grid = 0;
    if (grid == 0) {
        if (n_in != 33 || (size_t)out_size != O_END || ws_size < WS_END) { fprintf(stderr, "kernel_launch: unexpected sizes n_in %d out %d ws %zu\n", n_in, out_size, ws_size); grid = -1; return; }
        int dev = 0, cus = 0;
        hipGetDevice(&dev); hipDeviceGetAttribute(&cus, hipDeviceAttributeMultiprocessorCount, dev);
        hipFuncSetAttribute((const void*)mk, hipFuncAttributeMaxDynamicSharedMemorySize, LDS_BYTES);
        (void)hipGetLastError();
        grid = cus > 0 ? cus : 256;
    }
    if (grid < 0) return;
    const float* const* in = (const float* const*)d_in;
    float* out = (float*)d_out; unsigned char* ws = (unsigned char*)d_ws;
    bf16_t* XB = (bf16_t*)(ws + WS_XB); float* XF = (float*)(ws + WS_XF); bf16_t* H = (bf16_t*)(ws + WS_H); bf16_t* YC = (bf16_t*)(ws + WS_YC);
    float* PRE = (float*)(ws + WS_PRE); float* X1F = (float*)(ws + WS_X1F); bf16_t* X1B = (bf16_t*)(ws + WS_X1B); bf16_t* HF = (bf16_t*)(ws + WS_HF);
    float* KCS = (float*)(ws + WS_KCS); float* KCP = (float*)(ws + WS_KCP); unsigned long long* SEL = (unsigned long long*)(ws + WS_SEL);
    float* OC = (float*)(ws + WS_OC); float* OS = (float*)(ws + WS_OS); float* OW = (float*)(ws + WS_OW); float* YA = (float*)(ws + WS_YA); float* PL = (float*)(ws + WS_PL); float* HS = (float*)(ws + WS_HS);
    const int* pt = (const int*)d_in[8];
    Args a{}; for (int i = 0; i < 33; ++i) a.in[i] = in[i]; a.out = out; a.ws = ws;
    for (int l = 0; l < 2; ++l) {
        k_transpose_bf16<<<dim3(NINP / 32, DM / 32), dim3(32, 8), 0, stream>>>(in[9] + (size_t)l * DM * NIN, DM, NIN, (bf16_t*)(ws + WS_WIN) + (size_t)l * NINP * DM);
        k_transpose_bf16<<<dim3(DM / 32, DM / 32), dim3(32, 8), 0, stream>>>(in[26] + (size_t)l * DM * DM, DM, DM, (bf16_t*)(ws + WS_WOUT) + (size_t)l * DM * DM);
        k_transpose_bf16<<<dim3(DFF / 32, DM / 32), dim3(32, 8), 0, stream>>>(in[29] + (size_t)l * DM * DFF, DM, DFF, (bf16_t*)(ws + WS_WUP) + (size_t)l * DFF * DM);
        k_transpose_bf16<<<dim3(DM / 32, DFF / 32), dim3(32, 8), 0, stream>>>(in[30] + (size_t)l * DFF * DM, DFF, DM, (bf16_t*)(ws + WS_WDN) + (size_t)l * DM * DFF);
        k_compress_sample<<<(32 * 128 * 256) / 256, 256, 0, stream>>>(in[2] + (size_t)l * NPOOLPG * 128 * 512, pt, in[24] + l * 4096, in[25] + l * 4096, KCS + (size_t)l * 32 * 128 * 256);
    }
    k_x2bf<<<(MT * DM / 4 + 255) / 256, 256, 0, stream>>>(in[0], in[1], XB);
    for (int l = 0; l < 2; ++l) {
        a.layer = l;
        a.phase = 0; hipLaunchKernelGGL(mk, dim3(grid), dim3(512), LDS_BYTES, stream, a);
        k_sgemm<0><<<(8 * (NINP / 16)) / 4, 256, 0, stream>>>(XB + (size_t)MP * DM, DM, (const bf16_t*)(ws + WS_WIN) + (size_t)l * NINP * DM, NINP, DM, H, nullptr, nullptr,
                                                            out + O_KVS + (size_t)l * MS * 512, out + O_WINS + (size_t)l * 32 * 512 * 256);
        SsmP sp{in[10] + l * 2048, in[11] + l * 2048, in[12] + l * 32768, in[13] + l * 32768, in[14] + l * 32768, in[15] + l * 32768, in[16] + l * 512, in[17] + l * 32, in[18] + (size_t)l * 512 * 512, in[19] + l * 512};
        k_ssm_scan<<<(34 * 2048) / 256, 256, 0, stream>>>(sp, H, in[4] + (size_t)l * 32 * 2048, in[5] + (size_t)l * 32 * 2048, HS,
                                                          out + O_SREP + l * 2 * 2048, out + O_SIMP + l * 2 * 2048, out + O_SRES + l * 32 * 2048, out + O_SIMS + l * 32 * 2048);
        k_ssm_y<<<(MT * 512) / 256, 256, 0, stream>>>(sp, H, HS, YA);
        k_ssm_glu<<<(MT * 512) / 256, 256, 0, stream>>>(sp, YA, YC);
        CpP cp{in[20] + l * 3 * 512, in[21] + l * 512, in[22] + (size_t)l * 4 * 128 * 128, in[23] + l * 512, in[6] + (size_t)l * 32 * 2 * 512, in[7] + (size_t)l * 32 * 15 * 512};
        k_convpool1<<<(MT * 512) / 256, 256, 0, stream>>>(cp, H, YC, PL, out + O_CONVP + l * 2 * 2 * 512, out + O_CONVS + l * 32 * 2 * 512, out + O_POOLP + l * 2 * 15 * 512, out + O_POOLS + l * 32 * 15 * 512);
        k_pool2<<<(MT * 512) / 256, 256, 0, stream>>>(cp, PL, YC);
        k_compress_prompt<<<(2 * 64 * 256) / 256, 256, 0, stream>>>(H, in[24] + l * 4096, in[25] + l * 4096, KCP);
        k_cmp_topk<<<(MT * 2) / 4, 256, 0, stream>>>(H, KCP, KCS + (size_t)l * 32 * 128 * 256, OC, SEL);
        AttP ap{H, in[2] + (size_t)l * NPOOLPG * 128 * 512, in[3] + (size_t)l * 32 * 512 * 256, pt};
        k_attn_naive<0><<<(MT * 8) / 4, 256, 0, stream>>>(ap, SEL, OS);
        k_attn_naive<1><<<(MT * 8) / 4, 256, 0, stream>>>(ap, SEL, OW);
        k_combine<<<(MT * 512) / 256, 256, 0, stream>>>(H, OC, OS, OW, YC);
        k_wincopy<<<(32 * 508 * 64 + 255) / 256, 256, 0, stream>>>(in[3] + (size_t)l * 32 * 512 * 256, out + O_WINS + (size_t)l * 32 * 512 * 256);
        a.phase = 1; hipLaunchKernelGGL(mk, dim3(grid), dim3(512), LDS_BYTES, stream, a);
        k_sgemm<1><<<(8 * (DM / 16)) / 4, 256, 0, stream>>>(YC + (size_t)MP * DM, DM, (const bf16_t*)(ws + WS_WOUT) + (size_t)l * DM * DM, DM, DM, nullptr, PRE + (size_t)MP * DM,
                                                          l == 0 ? in[1] : XF + (size_t)MP * DM, nullptr, nullptr);
        k_ln<<<MT / 4, 256, 0, stream>>>(PRE, in[27] + l * DM, in[28] + l * DM, X1F, X1F + (size_t)MP * DM, X1B);
        a.phase = 2; hipLaunchKernelGGL(mk, dim3(grid), dim3(512), LDS_BYTES, stream, a);
        k_sgemm<2><<<(8 * (DFF / 16)) / 4, 256, 0, stream>>>(X1B + (size_t)MP * DM, DM, (const bf16_t*)(ws + WS_WUP) + (size_t)l * DFF * DM, DFF, DM, HF, nullptr, nullptr, nullptr, nullptr);
        a.phase = 3; hipLaunchKernelGGL(mk, dim3(grid), dim3(512), LDS_BYTES, stream, a);
        k_sgemm<1><<<(8 * (DM / 16)) / 4, 256, 0, stream>>>(HF + (size_t)MP * DFF, DFF, (const bf16_t*)(ws + WS_WDN) + (size_t)l * DM * DFF, DM, DFF, nullptr, PRE + (size_t)MP * DM,
                                                          X1F + (size_t)MP * DM, nullptr, nullptr);
        if (l == 0) k_ln<<<MT / 4, 256, 0, stream>>>(PRE, in[31] + l * DM, in[32] + l * DM, XF, XF + (size_t)MP * DM, XB);
        else k_ln<<<MT / 4, 256, 0, stream>>>(PRE, in[31] + l * DM, in[32] + l * DM, out + O_YP, out + O_YS, nullptr);
    }
}
```

```cpp
#include <hip/hip_runtime.h>
#include <cstdio>
#include <cstdint>

constexpr int DM = 2048, TP = 4096, MP = 8192, SBAT = 32, STOK = 4, MS = 128, MT = MP + MS, MPAD = 8448;
constexpr int NIN = 3864, NINP = 4096, DFF = 8192, GW = 512;
constexpr int PAST = 8192, NPOOLPG = 2560, NPG = 64;
constexpr int C_USSM = 0, C_GB = 512, C_GC = 1024, C_VC = 1536, C_UP = 2048, C_Q = 2560, C_KV = 3072, C_GATE = 3840;
constexpr float ALPHA = 1.4142135623730951f;
constexpr float LN_EPS = 1e-5f;
constexpr float NEGF = -1e30f;
constexpr size_t O_YP = 0, O_YS = O_YP + (size_t)MP * DM, O_KVP = O_YS + (size_t)MS * DM, O_KVS = O_KVP + (size_t)2 * MP * 512,
                 O_WINP = O_KVS + (size_t)2 * MS * 512, O_WINS = O_WINP + (size_t)2 * 2 * 512 * 256, O_SREP = O_WINS + (size_t)2 * 32 * 512 * 256,
                 O_SIMP = O_SREP + 2 * 2 * 2048, O_SRES = O_SIMP + 2 * 2 * 2048, O_SIMS = O_SRES + 2 * 32 * 2048, O_CONVP = O_SIMS + 2 * 32 * 2048,
                 O_CONVS = O_CONVP + 2 * 2 * 2 * 512, O_POOLP = O_CONVS + 2 * 32 * 2 * 512, O_POOLS = O_POOLP + 2 * 2 * 15 * 512, O_END = O_POOLS + 2 * 32 * 15 * 512;
static_assert(O_END == 35342336, "output size");
constexpr size_t MiB = 1u << 20;
constexpr size_t WS_CTL = 0, CTL_ZERO_BYTES = 1 * MiB;
constexpr size_t WS_WIN = 2 * MiB;
constexpr size_t WS_WOUT = WS_WIN + 32 * MiB;
constexpr size_t WS_WUP = WS_WOUT + 16 * MiB;
constexpr size_t WS_WDN = WS_WUP + 64 * MiB;
constexpr size_t WS_XB = WS_WDN + 64 * MiB;
constexpr size_t WS_XF = WS_XB + 34 * MiB;
constexpr size_t WS_H = WS_XF + 66 * MiB;
constexpr size_t WS_YC = WS_H + 68 * MiB;
constexpr size_t WS_PRE = WS_YC + 34 * MiB;
constexpr size_t WS_X1F = WS_PRE + 66 * MiB;
constexpr size_t WS_X1B = WS_X1F + 66 * MiB;
constexpr size_t WS_HF = WS_X1B + 34 * MiB;
constexpr size_t WS_KCS = WS_HF + 134 * MiB;
constexpr size_t WS_KCP = WS_KCS + 8 * MiB;
constexpr size_t WS_SEL = WS_KCP + 1 * MiB;
constexpr size_t WS_OC = WS_SEL + 1 * MiB;
constexpr size_t WS_OS = WS_OC + 18 * MiB;
constexpr size_t WS_OW = WS_OS + 18 * MiB;
constexpr size_t WS_YA = WS_OW + 18 * MiB;
constexpr size_t WS_PL = WS_YA + 18 * MiB;
constexpr size_t WS_HS = WS_PL + 18 * MiB;
constexpr size_t WS_END = WS_HS + 132 * MiB;

typedef unsigned short bf16_t;
__host__ __device__ __forceinline__ float bf2f(bf16_t v) { union { unsigned u; float f; } x; x.u = (unsigned)v << 16; return x.f; }
__host__ __device__ __forceinline__ bf16_t f2bf(float f) { union { unsigned u; float f; } x; x.f = f; unsigned u = x.u; return (bf16_t)((u + 0x7fffu + ((u >> 16) & 1u)) >> 16); }

namespace pg8 {
#define PG8_LAS __attribute__((address_space(3)))
typedef unsigned short bf16_t;
typedef short bf16x8 __attribute__((ext_vector_type(8)));
typedef float f32x4 __attribute__((ext_vector_type(4)));
typedef unsigned u32x4 __attribute__((ext_vector_type(4)));
constexpr int BM = 256, BK = 64, HALF = 128, HTB = HALF * BK * 2  , STAGE_BYTES = 8 * HTB, NXCD = 8, WGM = 8;

__host__ __device__ __forceinline__ int lds_byte(int r, int c) { const int st = (r >> 4) * 2 + (c >> 5), rr = r & 15, cc = c & 31, ob = rr * 64 + cc * 2; return st * 1024 + (ob ^ (((ob >> 9) & 1) << 5)); }
__host__ __device__ __forceinline__ void stage_rc(int b, int& R, int& C) { const int st = b / 1024, sb = b % 1024, swz = sb ^ (((sb >> 9) & 1) << 5); R = (st >> 1) * 16 + swz / 64; C = (st & 1) * 32 + (swz % 64) / 2; }
__host__ __device__ __forceinline__ int perm32(int rho) { const int n = rho >> 4, i = rho & 15; return 8 * (i >> 2) + 4 * n + (i & 3); }

struct Unit { int pm, pn; };
struct Gemm { const bf16_t* A; const bf16_t* Bt; int M, N, K; };

struct StaticOrder {
    int nM, nN, nwg, G, c;
    __host__ __device__ void init(int M, int N, int G_, int c_) { nM = M / BM; nN = N / BM; nwg = nM * nN; G = G_; c = c_; }
    __host__ __device__ bool next(int i, Unit& u) const {
        const long L = (long)i * G + c; if (L >= nwg) return false;
        int wgid = (int)L; { const int q = nwg / NXCD, r = nwg % NXCD, xcd = wgid % NXCD, off = wgid / NXCD; wgid = (xcd < r ? xcd * (q + 1) : r * (q + 1) + (xcd - r) * q) + off; }
        const int nig = WGM * nN, gid = wgid / nig, fm = gid * WGM, gsz = (nM - fm) < WGM ? (nM - fm) : WGM;
        u.pm = fm + ((wgid % nig) % gsz); u.pn = (wgid % nig) / gsz; return true;
    }
    __device__ __forceinline__ void a_ready(const Unit&) const {}
    __device__ __forceinline__ void done(const Unit&) const {}
};

__device__ __forceinline__ unsigned cvt_pk_bf16(float lo, float hi) { unsigned r; asm volatile("v_cvt_pk_bf16_f32 %0, %1, %2" : "=v"(r) : "v"(lo), "v"(hi)); return r; }
typedef float f32x2 __attribute__((ext_vector_type(2)));
struct EpiIn {
    static constexpr bool PERM = true, AFTER_DRAIN = false;
    bf16_t* H; float* okv; float* owin;
    __device__ __forceinline__ void operator()(const f32x4 (&acc)[2][2][4][2], const Unit& u, int wr, int wc, int fr, int fq) const {
        const int row0 = u.pm * BM + wr * 64 + fr, col0 = u.pn * BM + wc * 32 + 8 * fq;
#pragma unroll
        for (int ai = 0; ai < 2; ++ai)
#pragma unroll
            for (int m = 0; m < 4; ++m) { const int row = row0 + ai * HALF + m * 16;
#pragma unroll
                for (int bj = 0; bj < 2; ++bj) { const f32x4 v0 = acc[ai][bj][m][0], v1 = acc[ai][bj][m][1]; const int col = col0 + bj * HALF;
                    u32x4 w; w.x = cvt_pk_bf16(v0[0], v0[1]); w.y = cvt_pk_bf16(v0[2], v0[3]); w.z = cvt_pk_bf16(v1[0], v1[1]); w.w = cvt_pk_bf16(v1[2], v1[3]);
                    *(u32x4*)(H + (size_t)row * 4096 + col) = w;
                    if (u.pn == 12 || u.pn == 13) { float* p = okv + (size_t)row * 512 + (col - 3072); *(f32x4*)p = v0; *(f32x4*)(p + 4) = v1; }
                    if (u.pn == 14) { const int t = row & 4095, b = row >> 12; if (t >= 3584) { float* p = owin + ((size_t)(b * 512 + t - 3584) * 256 + (col - 3584)); *(f32x4*)p = v0; *(f32x4*)(p + 4) = v1; } }
                } }
    }
};
struct EpiRes {
    static constexpr bool PERM = true, AFTER_DRAIN = false;
    const float* res; float* pre; float alpha;
    __device__ __forceinline__ void operator()(const f32x4 (&acc)[2][2][4][2], const Unit& u, int wr, int wc, int fr, int fq) const {
        const int row0 = u.pm * BM + wr * 64 + fr, col0 = u.pn * BM + wc * 32 + 8 * fq;
#pragma unroll
        for (int ai = 0; ai < 2; ++ai)
#pragma unroll
            for (int m = 0; m < 4; ++m) { const int row = row0 + ai * HALF + m * 16;
#pragma unroll
                for (int bj = 0; bj < 2; ++bj) { const size_t off = (size_t)row * 2048 + col0 + bj * HALF;
                    const f32x4 r0 = *(const f32x4*)(res + off), r1 = *(const f32x4*)(res + off + 4);
                    *(f32x4*)(pre + off) = r0 * alpha + acc[ai][bj][m][0]; *(f32x4*)(pre + off + 4) = r1 * alpha + acc[ai][bj][m][1]; } }
    }
};
struct EpiRelu2 {
    static constexpr bool PERM = true, AFTER_DRAIN = false;
    bf16_t* O;
    __device__ __forceinline__ void operator()(const f32x4 (&acc)[2][2][4][2], const Unit& u, int wr, int wc, int fr, int fq) const {
        const int row0 = u.pm * BM + wr * 64 + fr, col0 = u.pn * BM + wc * 32 + 8 * fq;
#pragma unroll
        for (int ai = 0; ai < 2; ++ai)
#pragma unroll
            for (int m = 0; m < 4; ++m) { const int row = row0 + ai * HALF + m * 16;
#pragma unroll
                for (int bj = 0; bj < 2; ++bj) { f32x4 v0 = acc[ai][bj][m][0], v1 = acc[ai][bj][m][1];
#pragma unroll
                    for (int e = 0; e < 4; ++e) { const float a = fmaxf(v0[e], 0.f), b = fmaxf(v1[e], 0.f); v0[e] = a * a; v1[e] = b * b; }
                    u32x4 w; w.x = cvt_pk_bf16(v0[0], v0[1]); w.y = cvt_pk_bf16(v0[2], v0[3]); w.z = cvt_pk_bf16(v1[0], v1[1]); w.w = cvt_pk_bf16(v1[2], v1[3]);
                    *(u32x4*)(O + (size_t)row * 8192 + col0 + bj * HALF) = w; } }
    }
};
template <class Epi, class Sched, bool ALIGN_EPI = false, bool SP2 = false>
__device__ __forceinline__ void gemm_phase(PG8_LAS unsigned char* lds, const Gemm g, const Sched& S, const Epi& E) {
    int tid_l = threadIdx.x; asm volatile("" : "+v"(tid_l));
    const int tid = tid_l, wid = __builtin_amdgcn_readfirstlane(tid >> 6), lane = tid & 63, wr = wid >> 2, wc = wid & 3, fr = lane & 15, fq = lane >> 4;
    const int K = g.K, nt = K / BK;
    unsigned voffA[2], voffB[2];
#pragma unroll
    for (int i = 0; i < 2; ++i) { int R, C; stage_rc(tid * 16 + i * 8192, R, C); const int Rb = Epi::PERM ? ((R & ~31) + perm32(R & 31)) : R;
        voffA[i] = (unsigned)(R * K + C) * 2u; voffB[i] = (unsigned)(Rb * K + C) * 2u; }
    const size_t kstep = (size_t)(BK * 2);
    const size_t hstep = (size_t)HALF * K * 2;
    const size_t tstep = 2 * hstep;
    const unsigned ldsw = (unsigned)wid * 1024u;
    const int aoff = lds_byte(wr * 64 + fr, fq * 8), boff = lds_byte(wc * 32 + fr, fq * 8);
#define PG8_SA(b, h) (((b) * 2 + (h)) * HTB)
#define PG8_SB(b, h) ((4 + (b) * 2 + (h)) * HTB)
#define PG8_STAGE(bufoff, gbase, voff) do { _Pragma("unroll") for (int _i = 0; _i < 2; ++_i) \
        __builtin_amdgcn_global_load_lds((const unsigned*)((const char*)(gbase) + (voff)[_i]), (PG8_LAS unsigned*)(lds + (bufoff) + ldsw + _i * 8192), 16, 0, 0); } while (0)
#define PG8_LDA(dst, b, h) do { _Pragma("unroll") for (int m = 0; m < 4; ++m) _Pragma("unroll") for (int k = 0; k < 2; ++k) dst[m][k] = *(const PG8_LAS bf16x8*)(lds + PG8_SA(b, h) + aoff + m * 2048 + k * 1024); } while (0)
#define PG8_LDB(dst, b, h) do { _Pragma("unroll") for (int n = 0; n < 2; ++n) _Pragma("unroll") for (int k = 0; k < 2; ++k) dst[n][k] = *(const PG8_LAS bf16x8*)(lds + PG8_SB(b, h) + boff + n * 2048 + k * 1024); } while (0)
#define PG8_MMA(ai, bj, At, Bt) do { __builtin_amdgcn_s_setprio(1); _Pragma("unroll") for (int m = 0; m < 4; ++m) _Pragma("unroll") for (int n = 0; n < 2; ++n) _Pragma("unroll") for (int k = 0; k < 2; ++k) \
        acc[ai][bj][m][n] = __builtin_amdgcn_mfma_f32_16x16x32_bf16(Bt[n][k], At[m][k], acc[ai][bj][m][n], 0, 0, 0); __builtin_amdgcn_s_setprio(0); } while (0)
#define PG8_WAIT_V(n) asm volatile("s_waitcnt vmcnt(" #n ")" ::: "memory")
#define PG8_WAIT_L(n) asm volatile("s_waitcnt lgkmcnt(" #n ")" ::: "memory")
#define PG8_BAR __builtin_amdgcn_s_barrier()
#define PG8_SCHED __builtin_amdgcn_sched_barrier(0)
    Unit cur, nxt; int ui = 0;
    if (!S.next(0, cur)) return;
    f32x4 acc[2][2][4][2];
#pragma unroll
    for (int a = 0; a < 2; ++a)
#pragma unroll
        for (int b = 0; b < 2; ++b)
#pragma unroll
            for (int m = 0; m < 4; ++m)
#pragma unroll
                for (int n = 0; n < 2; ++n) acc[a][b][m][n] = (f32x4){0.f, 0.f, 0.f, 0.f};
    bf16x8 At[4][2], B0[2][2], B1[2][2];
    const char* cA = (const char*)g.A + (size_t)cur.pm * tstep; const char* cB = (const char*)g.Bt + (size_t)cur.pn * tstep;
    S.a_ready(cur);
    if constexpr (SP2) {
        PG8_STAGE(PG8_SB(0, 0), cB, voffB); PG8_STAGE(PG8_SB(0, 1), cB + hstep, voffB); PG8_STAGE(PG8_SA(0, 0), cA, voffA); PG8_STAGE(PG8_SA(0, 1), cA + hstep, voffA);
        if (wr == 1) PG8_BAR;
        PG8_WAIT_V(2); PG8_BAR;
        PG8_STAGE(PG8_SB(1, 0), cB + kstep, voffB); PG8_STAGE(PG8_SA(1, 0), cA + kstep, voffA); PG8_STAGE(PG8_SB(1, 1), cB + hstep + kstep, voffB);
        PG8_WAIT_V(6); PG8_BAR;
    } else {
        PG8_STAGE(PG8_SB(0, 0), cB, voffB); PG8_STAGE(PG8_SA(0, 0), cA, voffA); PG8_STAGE(PG8_SB(0, 1), cB + hstep, voffB); PG8_STAGE(PG8_SA(0, 1), cA + hstep, voffA);
        if (wr == 1) PG8_BAR;
        PG8_WAIT_V(4); PG8_BAR;
        PG8_STAGE(PG8_SB(1, 0), cB + kstep, voffB); PG8_STAGE(PG8_SA(1, 0), cA + kstep, voffA); PG8_STAGE(PG8_SB(1, 1), cB + hstep + kstep, voffB);
        PG8_WAIT_V(6); PG8_BAR;
    }
    for (;;) {
        const bool has_next = S.next(ui + 1, nxt);
        const char* nA = has_next ? (const char*)g.A + (size_t)nxt.pm * tstep : cA; const char* nB = has_next ? (const char*)g.Bt + (size_t)nxt.pn * tstep : cB;
        for (int t = 0; t < nt; t += 2) {
            const bool last = (t == nt - 2);
            const char* a1 = cA + (size_t)(t + 1) * kstep;
            const char* a2 = last ? nA : cA + (size_t)(t + 2) * kstep; const char* b2 = last ? nB : cB + (size_t)(t + 2) * kstep;
            const char* a3 = a2 + kstep; const char* b3 = b2 + kstep;
            if (last && has_next) S.a_ready(nxt);
            if constexpr (SP2) {
            PG8_LDB(B0, 0, 0); PG8_LDB(B1, 0, 1); PG8_SCHED; PG8_LDA(At, 0, 0); PG8_STAGE(PG8_SA(1, 1), a1 + hstep, voffA);
            PG8_WAIT_V(8); PG8_WAIT_L(0); PG8_BAR; PG8_MMA(0, 0, At, B0); PG8_MMA(0, 1, At, B1); PG8_BAR; PG8_SCHED;
            PG8_LDA(At, 0, 1); PG8_STAGE(PG8_SB(0, 0), b2, voffB); PG8_STAGE(PG8_SB(0, 1), b2 + hstep, voffB); PG8_STAGE(PG8_SA(0, 0), a2, voffA);
            PG8_WAIT_V(8); PG8_WAIT_L(0); PG8_BAR; PG8_MMA(1, 0, At, B0); PG8_MMA(1, 1, At, B1); PG8_BAR; PG8_SCHED;
            PG8_LDB(B0, 1, 0); PG8_LDB(B1, 1, 1); PG8_SCHED; PG8_LDA(At, 1, 0); PG8_STAGE(PG8_SA(0, 1), a2 + hstep, voffA);
            PG8_WAIT_V(8); PG8_WAIT_L(0); PG8_BAR; PG8_MMA(0, 0, At, B0); PG8_MMA(0, 1, At, B1); PG8_BAR; PG8_SCHED;
            PG8_LDA(At, 1, 1); PG8_STAGE(PG8_SB(1, 0), b3, voffB); PG8_STAGE(PG8_SB(1, 1), b3 + hstep, voffB); PG8_STAGE(PG8_SA(1, 0), a3, voffA);
            PG8_WAIT_V(8); PG8_WAIT_L(0); PG8_BAR; PG8_MMA(1, 0, At, B0); PG8_MMA(1, 1, At, B1); PG8_BAR; PG8_SCHED;
            } else {
            PG8_LDB(B0, 0, 0); PG8_SCHED; PG8_LDA(At, 0, 0); PG8_STAGE(PG8_SA(1, 1), a1 + hstep, voffA);
            PG8_WAIT_L(8); PG8_BAR; PG8_WAIT_L(0); PG8_MMA(0, 0, At, B0); PG8_BAR; PG8_SCHED;
            PG8_LDB(B1, 0, 1); PG8_STAGE(PG8_SB(0, 0), b2, voffB);
            PG8_BAR; PG8_WAIT_L(0); PG8_MMA(0, 1, At, B1); PG8_BAR;
            PG8_LDA(At, 0, 1); PG8_STAGE(PG8_SA(0, 0), a2, voffA);
            PG8_BAR; PG8_WAIT_L(0); PG8_MMA(1, 0, At, B0); PG8_BAR; PG8_SCHED;
            PG8_STAGE(PG8_SB(0, 1), b2 + hstep, voffB);
            PG8_WAIT_V(6); PG8_BAR; PG8_MMA(1, 1, At, B1); PG8_BAR;
            PG8_LDB(B0, 1, 0); PG8_SCHED; PG8_LDA(At, 1, 0); PG8_STAGE(PG8_SA(0, 1), a2 + hstep, voffA);
            PG8_WAIT_L(8); PG8_BAR; PG8_WAIT_L(0); PG8_MMA(0, 0, At, B0); PG8_BAR; PG8_SCHED;
            PG8_LDB(B1, 1, 1); PG8_STAGE(PG8_SB(1, 0), b3, voffB);
            PG8_BAR; PG8_WAIT_L(0); PG8_MMA(0, 1, At, B1); PG8_BAR;
            PG8_LDA(At, 1, 1); PG8_STAGE(PG8_SA(1, 0), a3, voffA);
            PG8_BAR; PG8_WAIT_L(0); PG8_MMA(1, 0, At, B0); PG8_BAR; PG8_SCHED;
            PG8_STAGE(PG8_SB(1, 1), b3 + hstep, voffB);
            PG8_WAIT_V(6); PG8_BAR; PG8_MMA(1, 1, At, B1); PG8_BAR;
            }
        }
        if constexpr (ALIGN_EPI) { if (wr == 0) PG8_BAR; }
        if constexpr (!Epi::AFTER_DRAIN) { E(acc, cur, wr, wc, fr, fq); S.done(cur); }
        if (!has_next) break;
#pragma unroll
        for (int a = 0; a < 2; ++a)
#pragma unroll
            for (int b = 0; b < 2; ++b)
#pragma unroll
                for (int m = 0; m < 4; ++m)
#pragma unroll
                    for (int n = 0; n < 2; ++n) acc[a][b][m][n] = (f32x4){0.f, 0.f, 0.f, 0.f};
        cur = nxt; cA = nA; cB = nB; ++ui;
        if constexpr (ALIGN_EPI) { if (wr == 1) PG8_BAR; }
    }
    PG8_WAIT_V(0);
    if constexpr (!ALIGN_EPI) { if (wr == 0) PG8_BAR; }
    PG8_BAR;
    if constexpr (Epi::AFTER_DRAIN) { E.fused(acc, cur, wr, wc, fr, fq, lds, wid, lane); S.done(cur); }
#undef PG8_SA
#undef PG8_SB
#undef PG8_STAGE
#undef PG8_LDA
#undef PG8_LDB
#undef PG8_MMA
#undef PG8_WAIT_V
#undef PG8_WAIT_L
#undef PG8_BAR
#undef PG8_SCHED
}
}
typedef float f32x4 __attribute__((ext_vector_type(4)));
typedef short bf16x8 __attribute__((ext_vector_type(8)));
typedef unsigned u32x4 __attribute__((ext_vector_type(4)));
typedef unsigned u32x2 __attribute__((ext_vector_type(2)));

__device__ __forceinline__ float wave_sum(float v) {
#pragma unroll
    for (int o = 1; o < 64; o <<= 1) v += __shfl_xor(v, o);
    return v;
}
__device__ __forceinline__ float wave_max(float v) {
#pragma unroll
    for (int o = 1; o < 64; o <<= 1) v = fmaxf(v, __shfl_xor(v, o));
    return v;
}

__device__ __forceinline__ void k_x2bf(const int vb, const int vt, const float* __restrict__ xp, const float* __restrict__ xs, bf16_t* __restrict__ XB) {
    const size_t i = ((size_t)vb * 256 + vt) * 4;
    if (i >= (size_t)MT * DM) return;
    const float* src = (i < (size_t)MP * DM) ? xp + i : xs + (i - (size_t)MP * DM);
    const f32x4 v = *(const f32x4*)src;
    u32x2 w; w.x = (unsigned)f2bf(v[0]) | ((unsigned)f2bf(v[1]) << 16); w.y = (unsigned)f2bf(v[2]) | ((unsigned)f2bf(v[3]) << 16);
    *(u32x2*)(XB + i) = w;
}

template <int MODE>
__device__ __forceinline__ void k_sgemm(const int vb, const int vt, const bf16_t* __restrict__ A, int lda, const bf16_t* __restrict__ Wt, int N, int K,
                                                bf16_t* __restrict__ OB, float* __restrict__ OF, const float* __restrict__ res, float* __restrict__ okv, float* __restrict__ owin) {
    const int wave = (vb * 256 + vt) >> 6, lane = vt & 63;
    const int ntn = N / 16, mt = wave / ntn, nt = wave % ntn;
    if (mt >= 8) return;
    const int fr = lane & 15, fq = lane >> 4;
    const bf16_t* ap = A + (size_t)(mt * 16 + fr) * lda + fq * 8;
    const bf16_t* wp = Wt + (size_t)(nt * 16 + fr) * K + fq * 8;
    f32x4 acc = {0.f, 0.f, 0.f, 0.f};
#pragma unroll 4
    for (int k = 0; k < K; k += 32) {
        const bf16x8 a = *(const bf16x8*)(ap + k), w = *(const bf16x8*)(wp + k);
        acc = __builtin_amdgcn_mfma_f32_16x16x32_bf16(w, a, acc, 0, 0, 0);
    }
    const int m = mt * 16 + fr, n = nt * 16 + fq * 4;
    if (MODE == 0) {
        if (n < NIN) {
            u32x2 w; w.x = (unsigned)f2bf(acc[0]) | ((unsigned)f2bf(acc[1]) << 16); w.y = (unsigned)f2bf(acc[2]) | ((unsigned)f2bf(acc[3]) << 16);
            *(u32x2*)(OB + (size_t)(MP + m) * 4096 + n) = w;
            if (n >= 3072 && n < 3584) *(f32x4*)(okv + (size_t)m * 512 + (n - 3072)) = acc;
            if (n >= 3584 && n < 3840) { const int bs = m >> 2, ts = m & 3; *(f32x4*)(owin + ((size_t)(bs * 512 + 508 + ts) * 256 + (n - 3584))) = acc; }
        }
    } else if (MODE == 1) {
        const size_t off = (size_t)m * 2048 + n; const f32x4 r = *(const f32x4*)(res + off);
        *(f32x4*)(OF + off) = r * ALPHA + acc;
    } else {
        f32x4 v = acc;
#pragma unroll
        for (int e = 0; e < 4; ++e) { const float a = fmaxf(v[e], 0.f); v[e] = a * a; }
        u32x2 w; w.x = (unsigned)f2bf(v[0]) | ((unsigned)f2bf(v[1]) << 16); w.y = (unsigned)f2bf(v[2]) | ((unsigned)f2bf(v[3]) << 16);
        *(u32x2*)(OB + (size_t)(MP + m) * 8192 + n) = w;
    }
}

struct SsmP { const float *a_re, *a_im, *b_re, *b_im, *c_re, *c_im, *d, *log_dt, *w_glu, *b_glu; };
__device__ __forceinline__ void k_ssm_scan(const int vb, const int vt, SsmP P, const bf16_t* __restrict__ H, const float* __restrict__ s_re, const float* __restrict__ s_im,
                           float* __restrict__ HS, float* __restrict__ o_rep, float* __restrict__ o_imp, float* __restrict__ o_res, float* __restrict__ o_ims) {
    const int id = vb * 256 + vt;
    if (id >= 34 * 2048) return;
    const int s = id / 2048, gn = id % 2048, g = gn / 64;
    const float dt = expf(P.log_dt[g]), are = P.a_re[gn], aim = P.a_im[gn];
    const float mag = expf(dt * are), abr = mag * cosf(dt * aim), abi = mag * sinf(dt * aim);
    const float den = are * are + aim * aim, nr = abr - 1.0f;
    const float fre = (nr * are + abi * aim) / den, fim = (abi * are - nr * aim) / den;
    float bbr[16], bbi[16];
#pragma unroll
    for (int c = 0; c < 16; ++c) { const float br = P.b_re[gn * 16 + c], bi = P.b_im[gn * 16 + c]; bbr[c] = fre * br - fim * bi; bbi[c] = fre * bi + fim * br; }
    float hr = 0.f, hi = 0.f; int T = TP, m0 = s * TP;
    if (s >= 2) { const int bs = s - 2; T = STOK; m0 = MP + bs * STOK; hr = s_re[bs * 2048 + gn]; hi = s_im[bs * 2048 + gn]; }
    for (int t = 0; t < T; ++t) {
        const bf16_t* up = H + (size_t)(m0 + t) * 4096 + C_USSM + g * 16;
        const u32x4 w0 = *(const u32x4*)up, w1 = *(const u32x4*)(up + 8);
        float u[16];
#pragma unroll
        for (int e = 0; e < 4; ++e) { u[2 * e] = __uint_as_float(w0[e] << 16); u[2 * e + 1] = __uint_as_float(w0[e] & 0xffff0000u); u[8 + 2 * e] = __uint_as_float(w1[e] << 16); u[8 + 2 * e + 1] = __uint_as_float(w1[e] & 0xffff0000u); }
        float bur = 0.f, bui = 0.f;
#pragma unroll
        for (int c = 0; c < 16; ++c) { bur += bbr[c] * u[c]; bui += bbi[c] * u[c]; }
        const float nhr = abr * hr - abi * hi + bur, nhi = abr * hi + abi * hr + bui;
        hr = nhr; hi = nhi;
        float* hp = HS + ((size_t)(m0 + t) * 2048 + gn) * 2; hp[0] = hr; hp[1] = hi;
    }
    if (s < 2) { o_rep[s * 2048 + gn] = hr; o_imp[s * 2048 + gn] = hi; } else { o_res[(s - 2) * 2048 + gn] = hr; o_ims[(s - 2) * 2048 + gn] = hi; }
}
__device__ __forceinline__ float gelu_tanh(float x) { const float u = 0.7978845608028654f * (x + 0.044715f * x * x * x); return 0.5f * x * (1.0f + tanhf(u)); }
__device__ __forceinline__ void k_ssm_y(const int vb, const int vt, SsmP P, const bf16_t* __restrict__ H, const float* __restrict__ HS, float* __restrict__ YA) {
    const int id = vb * 256 + vt;
    if (id >= MT * 512) return;
    const int m = id / 512, ch = id % 512, g = ch / 16;
    const float* hp = HS + ((size_t)m * 2048 + g * 64) * 2; const float* cr = P.c_re + ch * 64; const float* ci = P.c_im + ch * 64;
    float y = 0.f;
    for (int n = 0; n < 64; ++n) y += cr[n] * hp[2 * n] - ci[n] * hp[2 * n + 1];
    y += P.d[ch] * bf2f(H[(size_t)m * 4096 + C_USSM + ch]);
    YA[id] = gelu_tanh(y);
}
__device__ __forceinline__ void k_ssm_glu(const int vb, const int vt, SsmP P, const float* __restrict__ YA, bf16_t* __restrict__ YC) {
    const int id = vb * 256 + vt;
    if (id >= MT * 512) return;
    const int m = id / 512, j = id % 512;
    const float* yr = YA + (size_t)m * 512; float z = P.b_glu[j];
    for (int k = 0; k < 512; ++k) z += yr[k] * P.w_glu[k * 512 + j];
    YC[(size_t)m * 2048 + j] = f2bf(yr[j] * (1.0f / (1.0f + expf(-z))));
}

struct CpP { const float *conv_w, *conv_b, *pool_w, *pool_scale, *st_conv, *st_pool; };
__device__ __forceinline__ void k_convpool1(const int vb, const int vt, CpP P, const bf16_t* __restrict__ H, bf16_t* __restrict__ YC, float* __restrict__ PL,
                            float* __restrict__ o_convp, float* __restrict__ o_convs, float* __restrict__ o_poolp, float* __restrict__ o_pools) {
    const int id = vb * 256 + vt;
    if (id >= MT * 512) return;
    const int m = id / 512, ch = id % 512;
    const bool smp = m >= MP; const int b = smp ? (m - MP) >> 2 : m >> 12, t = smp ? (m - MP) & 3 : m & 4095, T = smp ? STOK : TP, m0 = m - t;
    float e[3];
#pragma unroll
    for (int j = 0; j < 3; ++j) { const int tt = t - 2 + j;
        if (tt >= 0) { const bf16_t* r = H + (size_t)(m0 + tt) * 4096; e[j] = bf2f(r[C_GC + ch]) * bf2f(r[C_VC + ch]); }
        else e[j] = smp ? P.st_conv[(b * 2 + (2 + tt)) * 512 + ch] : 0.f; }
    const float conv = P.conv_b[ch] + P.conv_w[ch] * e[0] + P.conv_w[512 + ch] * e[1] + P.conv_w[1024 + ch] * e[2];
    YC[(size_t)m * 2048 + 512 + ch] = f2bf(bf2f(H[(size_t)m * 4096 + C_GB + ch]) * conv);
    if (t >= T - 2) { if (smp) o_convs[(b * 2 + (t - (T - 2))) * 512 + ch] = e[2]; else o_convp[(b * 2 + (t - (T - 2))) * 512 + ch] = e[2]; }
    const int w = 2 << (ch >> 7); float sum = 0.f;
    for (int s = t - w + 1; s <= t; ++s) { sum += (s >= 0) ? bf2f(H[(size_t)(m0 + s) * 4096 + C_UP + ch]) : (smp ? P.st_pool[(b * 15 + (15 + s)) * 512 + ch] : 0.f); }
    const float ut = bf2f(H[(size_t)m * 4096 + C_UP + ch]);
    const int cnt = min(t + 1 + (smp ? 15 : 0), w);
    PL[id] = sum / (float)cnt - ut;
    if (smp) { o_pools[(b * 15 + 11 + t) * 512 + ch] = ut; if (t == 0) { for (int i = 0; i < 11; ++i) o_pools[(b * 15 + i) * 512 + ch] = P.st_pool[(b * 15 + i + 4) * 512 + ch]; } }
    else if (t >= T - 15) o_poolp[(b * 15 + (t - (T - 15))) * 512 + ch] = ut;
}
__device__ __forceinline__ void k_pool2(const int vb, const int vt, CpP P, const float* __restrict__ PL, bf16_t* __restrict__ YC) {
    const int id = vb * 256 + vt;
    if (id >= MT * 512) return;
    const int m = id / 512, j = id % 512, gi = j >> 7, dd = j & 127;
    const float* pr = PL + (size_t)m * 512 + gi * 128; const float* w = P.pool_w + (size_t)gi * 128 * 128 + dd;
    float y = 0.f;
    for (int c = 0; c < 128; ++c) y += pr[c] * w[c * 128];
    YC[(size_t)m * 2048 + 1024 + j] = f2bf(y * P.pool_scale[j]);
}

__device__ __forceinline__ void k_compress_prompt(const int vb, const int vt, const bf16_t* __restrict__ H, const float* __restrict__ wck, const float* __restrict__ wcv, float* __restrict__ KCP) {
    const int id = vb * 256 + vt;
    if (id >= 2 * 64 * 256) return;
    const int gd = id & 127, kv = (id >> 7) & 1, j = (id >> 8) & 63, b = id >> 14, d = gd & 63;
    const float* w = kv ? wcv : wck; float s = 0.f;
    for (int k = 0; k < 64; ++k) s += bf2f(H[(size_t)(b * TP + j * 64 + k) * 4096 + C_KV + kv * 128 + gd]) * w[k * 64 + d];
    KCP[id] = s;
}
__device__ __forceinline__ void k_compress_sample(const int vb, const int vt, const float* __restrict__ cache  , const int* __restrict__ pt, const float* __restrict__ wck, const float* __restrict__ wcv, float* __restrict__ KCS) {
    const int id = vb * 256 + vt;
    if (id >= 32 * 128 * 256) return;
    const int gd = id & 127, kv = (id >> 7) & 1, j = (id >> 8) & 127, bs = id >> 15, d = gd & 63;
    const float* w = kv ? wcv : wck;
    const int page = pt[bs * NPG + (j >> 1)];
    const float* base = cache + ((size_t)page * 128 + (j & 1) * 64) * 512 + kv * 128 + gd;
    float s = 0.f;
    for (int k = 0; k < 64; ++k) s += base[(size_t)k * 512] * w[k * 64 + d];
    KCS[id] = s;
}
__device__ __forceinline__ void k_cmp_topk(const int vb, const int vt, const bf16_t* __restrict__ H, const float* __restrict__ KCP, const float* __restrict__ KCS,
                                                   float* __restrict__ OC, unsigned long long* __restrict__ SEL) {
    const int wv = (vb * 256 + vt) >> 6, lane = vt & 63;
    if (wv >= MT * 2) return;
    const int m = wv >> 1, g = wv & 1;
    const bool smp = m >= MP; const int b = smp ? (m - MP) >> 2 : m >> 12, t = smp ? (m - MP) & 3 : m & 4095;
    const int pos = smp ? PAST + t : t, cur = pos >> 6;
    const float* kc0; const float* kc1; bool ex1 = smp;
    if (smp) { kc0 = KCS + ((size_t)(b * 128 + lane) * 2) * 128 + g * 64; kc1 = KCS + ((size_t)(b * 128 + lane + 64) * 2) * 128 + g * 64; }
    else { kc0 = KCP + ((size_t)(b * 64 + lane) * 2) * 128 + g * 64; kc1 = kc0; }
    const bool cp0 = (64 * lane + 63 <= pos), cp1 = ex1 && (64 * (lane + 64) + 63 <= pos);
    float imp0 = 0.f, imp1 = 0.f;
    for (int r = 0; r < 4; ++r) {
        const bf16_t* q = H + (size_t)m * 4096 + C_Q + (g * 4 + r) * 64;
        float s0 = 0.f, s1 = 0.f;
        for (int d = 0; d < 64; ++d) { const float qv = bf2f(q[d]); s0 += qv * kc0[d]; s1 += qv * kc1[d]; }
        s0 = cp0 ? s0 * 0.125f : NEGF; s1 = cp1 ? s1 * 0.125f : NEGF;
        const float mx = wave_max(fmaxf(s0, s1));
        const float e0 = cp0 ? expf(s0 - mx) : 0.f, e1 = cp1 ? expf(s1 - mx) : 0.f;
        const float sum = wave_sum(e0 + e1), inv = sum > 0.f ? 1.0f / sum : 0.f;
        const float p0 = e0 * inv, p1 = e1 * inv;
        imp0 += p0; imp1 += p1;
        float o = 0.f;
        for (int d = 0; d < 64; ++d) { const float v = wave_sum(p0 * kc0[128 + d] + (ex1 ? p1 * kc1[128 + d] : 0.f)); if (lane == d) o = v; }
        OC[(size_t)m * 512 + (g * 4 + r) * 64 + lane] = o;
    }
    const int j0 = lane, j1 = lane + 64;
    const float sc0 = (j0 == 0 || j0 == cur || j0 == cur - 1) ? 5.0f : ((64 * j0 <= pos) ? imp0 : -1.0f);
    const float sc1 = (j1 == 0 || j1 == cur || j1 == cur - 1) ? 5.0f : ((64 * j1 <= pos) ? imp1 : -1.0f);
    int rk0 = 0, rk1 = 0;
    for (int jp = 0; jp < 64; ++jp) {
        const float a = __shfl(sc0, jp);
        rk0 += (a > sc0 || (a == sc0 && jp < j0)) ? 1 : 0;
        if (smp) { rk1 += (a > sc1 || (a == sc1 && jp < j1)) ? 1 : 0;
            const float c = __shfl(sc1, jp); const int jq = jp + 64;
            rk0 += (c > sc0 || (c == sc0 && jq < j0)) ? 1 : 0; rk1 += (c > sc1 || (c == sc1 && jq < j1)) ? 1 : 0; }
    }
    if (smp) { rk0 += (5.0f > sc0) ? 1 : 0; rk1 += (5.0f > sc1) ? 1 : 0; }
    const unsigned long long m0 = __ballot(rk0 < 16), m1 = smp ? __ballot(rk1 < 16) : 0ull;
    if (lane == 0) { unsigned long long* sp = SEL + (size_t)wv * 3; sp[0] = m0; sp[1] = m1; sp[2] = smp ? 1ull : 0ull; }
}
struct AttP { const bf16_t* H; const float* cache; const float* wcache; const int* pt; };
__device__ __forceinline__ float kv_elem(const AttP& A, bool smp, int b, int g, int slot, int kp, int d) {
    if (!smp) return bf2f(A.H[(size_t)(b * TP + kp) * 4096 + C_KV + slot * 128 + g * 64 + d]);
    if (kp >= PAST) return bf2f(A.H[(size_t)(MP + b * STOK + (kp - PAST)) * 4096 + C_KV + slot * 128 + g * 64 + d]);
    if (slot < 4) { const int page = A.pt[b * NPG + (kp >> 7)]; return A.cache[((size_t)page * 128 + (kp & 127)) * 512 + slot * 128 + g * 64 + d]; }
    return A.wcache[((size_t)b * 512 + (kp - (PAST - 512))) * 256 + (slot - 4) * 128 + g * 64 + d];
}
template <int BR>
__device__ __forceinline__ void k_attn_naive(const int vb, const int vt, AttP A, const unsigned long long* __restrict__ SEL, float* __restrict__ O) {
    const int wv = (vb * 256 + vt) >> 6, lane = vt & 63;
    if (wv >= MT * 8) return;
    const int m = wv >> 3, h = wv & 7, g = h >> 2;
    const bool smp = m >= MP; const int b = smp ? (m - MP) >> 2 : m >> 12, t = smp ? (m - MP) & 3 : m & 4095;
    const int pos = smp ? PAST + t : t;
    const bf16_t* qp = A.H + (size_t)m * 4096 + C_Q + h * 64;
    unsigned long long mk0 = 0, mk1 = 0, mk2 = 0;
    if (BR == 0) { const unsigned long long* sp = SEL + (size_t)(m * 2 + g) * 3; mk0 = sp[0]; mk1 = sp[1]; mk2 = sp[2]; }
    float mrun = NEGF, l = 0.f, o = 0.f;
    const int nchunk = BR == 0 ? 16 : 8;
    for (int c = 0; c < nchunk; ++c) {
        int kp0;
        if (BR == 0) { int kb; if (mk0) { kb = __builtin_ctzll(mk0); mk0 &= mk0 - 1; } else if (mk1) { kb = 64 + __builtin_ctzll(mk1); mk1 &= mk1 - 1; } else if (mk2) { kb = 128; mk2 = 0; } else break; kp0 = kb * 64; }
        else kp0 = pos - 511 + 64 * c;
        const int kp = kp0 + lane;
        const bool valid = (kp >= 0) && (kp <= pos);
        float s = NEGF;
        if (valid) { float a = 0.f;
#pragma unroll 4
            for (int d = 0; d < 64; ++d) a += bf2f(qp[d]) * kv_elem(A, smp, b, g, BR == 0 ? 2 : 4, kp, d);
            s = a * 0.125f; }
        const float bm = wave_max(s), mnew = fmaxf(mrun, bm), alpha = expf(mrun - mnew);
        const float e = valid ? expf(s - mnew) : 0.f;
        l = l * alpha + wave_sum(e); o *= alpha; mrun = mnew;
        for (int k = 0; k < 64; ++k) { const float ek = __shfl(e, k); if (ek != 0.f) o += ek * kv_elem(A, smp, b, g, BR == 0 ? 3 : 5, kp0 + k, lane); }
    }
    O[(size_t)m * 512 + h * 64 + lane] = o / l;
}
__device__ __forceinline__ void k_combine(const int vb, const int vt, const bf16_t* __restrict__ H, const float* __restrict__ OC, const float* __restrict__ OS, const float* __restrict__ OW, bf16_t* __restrict__ YC) {
    const int id = vb * 256 + vt;
    if (id >= MT * 512) return;
    const int m = id / 512, hd = id % 512, h = hd >> 6;
    const bf16_t* gp = H + (size_t)m * 4096 + C_GATE + h * 3;
    const float g0 = 1.f / (1.f + expf(-bf2f(gp[0]))), g1 = 1.f / (1.f + expf(-bf2f(gp[1]))), g2 = 1.f / (1.f + expf(-bf2f(gp[2])));
    YC[(size_t)m * 2048 + 1536 + hd] = f2bf(g0 * OC[id] + g1 * OS[id] + g2 * OW[id]);
}
__device__ __forceinline__ void k_wincopy(const int vb, const int vt, const float* __restrict__ wcache, float* __restrict__ owin) {
    const size_t id = (size_t)vb * 256 + vt;
    if (id >= (size_t)32 * 508 * 64) return;
    const int bs = (int)(id / (508 * 64)); const size_t r = id % (508 * 64);
    *(f32x4*)(owin + (size_t)bs * 512 * 256 + r * 4) = *(const f32x4*)(wcache + (size_t)bs * 512 * 256 + 4 * 256 + r * 4);
}
__device__ __forceinline__ void k_ln(const int vb, const int vt, const float* __restrict__ PRE, const float* __restrict__ gam, const float* __restrict__ bet,
                                             float* __restrict__ outFp, float* __restrict__ outFs, bf16_t* __restrict__ outB) {
    const int m = (vb * 256 + vt) >> 6, lane = vt & 63;
    if (m >= MT) return;
    const float* pr = PRE + (size_t)m * DM;
    f32x4 v[8]; float s = 0.f;
#pragma unroll
    for (int j = 0; j < 8; ++j) { v[j] = *(const f32x4*)(pr + j * 256 + lane * 4); s += (v[j][0] + v[j][1]) + (v[j][2] + v[j][3]); }
    const float mean = wave_sum(s) * (1.0f / DM); float s2 = 0.f;
#pragma unroll
    for (int j = 0; j < 8; ++j) { v[j] = v[j] - mean; s2 += (v[j][0] * v[j][0] + v[j][1] * v[j][1]) + (v[j][2] * v[j][2] + v[j][3] * v[j][3]); }
    const float rstd = 1.0f / sqrtf(wave_sum(s2) * (1.0f / DM) + LN_EPS);
    float* of = (m < MP) ? outFp + (size_t)m * DM : outFs + (size_t)(m - MP) * DM;
#pragma unroll
    for (int j = 0; j < 8; ++j) { const int c = j * 256 + lane * 4; const f32x4 gg = *(const f32x4*)(gam + c), bb = *(const f32x4*)(bet + c);
        const f32x4 y = v[j] * rstd * gg + bb; *(f32x4*)(of + c) = y;
        if (outB) { u32x2 w; w.x = (unsigned)f2bf(y[0]) | ((unsigned)f2bf(y[1]) << 16); w.y = (unsigned)f2bf(y[2]) | ((unsigned)f2bf(y[3]) << 16); *(u32x2*)(outB + (size_t)m * DM + c) = w; } }
}
constexpr int NWAVES = 8;
constexpr int RING_OFF = 0, RING_BYTES = 131072;
constexpr int LDSCTL_OFF = RING_BYTES, MISC_OFF = LDSCTL_OFF + 320;
constexpr int LDS_BYTES = 147456;
constexpr int CW_TMO = 0, CW_BAR = 4096;
#define GAS __attribute__((address_space(1)))
#define LAS __attribute__((address_space(3)))
typedef GAS unsigned gu32;
#define RLX_AGENT __ATOMIC_RELAXED, __HIP_MEMORY_SCOPE_AGENT
#define LDS_WAIT() asm volatile("s_waitcnt lgkmcnt(0)" ::: "memory")
#define VM_WAIT() asm volatile("s_waitcnt vmcnt(0)" ::: "memory")
#define XB_TMO      128
#define XB_XCNT(j)  (256  + 64 * (j))
#define XB_XSUB(j)  (1280 + 64 * (j))
#define XB_XGEN(j)  (2304 + 64 * (j))
#define XB_TOP      3328
#define XB_TOPGEN   3392
#define XCD_BAR_WORDS 3456
#define XB_SPIN_CAP (1u << 18)

__device__ __forceinline__ unsigned xb_ld(unsigned* p)              { return __hip_atomic_load(p, __ATOMIC_RELAXED, __HIP_MEMORY_SCOPE_AGENT); }
__device__ __forceinline__ unsigned xb_add(unsigned* p, unsigned v) { return __hip_atomic_fetch_add(p, v, __ATOMIC_RELAXED, __HIP_MEMORY_SCOPE_AGENT); }
__device__ __forceinline__ unsigned xb_xcc_id() { return (unsigned)__builtin_amdgcn_s_getreg((3 << 11) | 20) & 0xFu; }
#define XB_SPIN(cond, bar) do { unsigned _sp = 0; while (cond) { __builtin_amdgcn_s_sleep(1); \
    if ((++_sp & 255u) == 0u) { if (xb_ld(&(bar)[XB_TMO])) break; if (_sp > XB_SPIN_CAP) { atomicAdd(&(bar)[XB_TMO], 1u); break; } } } } while (0)

struct XcdBarrier {
    unsigned* bar; unsigned x;
    volatile LAS unsigned* st;
};

__device__ __forceinline__ XcdBarrier xcd_barrier_post(unsigned* bar, volatile LAS unsigned* st) {
    XcdBarrier b; b.bar = bar; b.x = xb_xcc_id(); b.st = st;
    if (threadIdx.x == 0) (void)xb_add(&bar[XB_XCNT(b.x)], 1u);
    return b;
}
__device__ __forceinline__ void xcd_barrier_complete(unsigned* bar, unsigned x, unsigned& nloc, unsigned& nx) {
    const unsigned G = gridDim.x * gridDim.y * gridDim.z;
    unsigned sum, cnt, mine, sp = 0u;
    for (;;) {
        sum = 0u; cnt = 0u; mine = 0u;
#pragma unroll
        for (unsigned j = 0; j < 16; ++j) { const unsigned c = xb_ld(&bar[XB_XCNT(j)]); sum += c; cnt += (c > 0u) ? 1u : 0u; mine = (j == x) ? c : mine; }
        if (sum == G) break;
        __builtin_amdgcn_s_sleep(1);
        if ((++sp & 255u) == 0u) { if (xb_ld(&bar[XB_TMO])) break; if (sp > XB_SPIN_CAP) { atomicAdd(&bar[XB_TMO], 1u); break; } }
    }
    nloc = mine > 0u ? mine : 1u; nx = cnt > 0u ? cnt : 1u;
}

__device__ __forceinline__ void xcd_barrier(const XcdBarrier& b) {
    asm volatile("s_waitcnt vmcnt(0)" ::: "memory");
    __syncthreads();
    if (threadIdx.x == 0) {
        unsigned* bar = b.bar;
        __builtin_amdgcn_s_waitcnt(0);
        unsigned nloc = b.st[0], nx = b.st[1];
        if (nloc == 0u) { xcd_barrier_complete(bar, b.x, nloc, nx); b.st[0] = nloc; b.st[1] = nx; }
        const unsigned old = xb_add(&bar[XB_XSUB(b.x)], 1u);
        const unsigned gen = old / nloc;
        if (old + 1u == (gen + 1u) * nloc) {
            __builtin_amdgcn_fence(__ATOMIC_RELEASE, "agent");
            asm volatile("s_waitcnt vmcnt(0)" ::: "memory");
            const unsigned og = xb_add(&bar[XB_TOP], 1u);
            const unsigned tg = og / nx;
            if (og + 1u == (tg + 1u) * nx) xb_add(&bar[XB_TOPGEN], 1u);
            else XB_SPIN(xb_ld(&bar[XB_TOPGEN]) == tg, bar);
            __builtin_amdgcn_fence(__ATOMIC_ACQUIRE, "agent");
            xb_add(&bar[XB_XGEN(b.x)], 1u);
            asm volatile("s_waitcnt vmcnt(0)" ::: "memory");
        } else {
            XB_SPIN(xb_ld(&bar[XB_XGEN(b.x)]) == gen, bar);
            __builtin_amdgcn_fence(__ATOMIC_ACQUIRE, "agent");
            asm volatile("s_waitcnt vmcnt(0)" ::: "memory");
        }
    }
    __syncthreads();
}

__device__ __forceinline__ void transpose_item(const float* __restrict__ W, int K, int N, int Npad, bf16_t* __restrict__ WT, LAS float* scr, int item, int lane) {
    const int nblk = Npad / 32, kb = item / nblk, nb = item % nblk, k0 = 64 * kb, n0 = 32 * nb, n = n0 + (lane & 31);
#pragma unroll 8
    for (int i = 0; i < 32; ++i) { const int kk = 2 * i + (lane >> 5); scr[kk * 33 + (lane & 31)] = (n < N) ? W[(size_t)(k0 + kk) * N + n] : 0.f; }
    LDS_WAIT(); asm volatile("" ::: "memory");
    const int c = lane & 7;
#pragma unroll
    for (int j = 0; j < 4; ++j) { const int nn = (lane >> 3) + 8 * j; const LAS float* s = scr + (8 * c) * 33 + nn;
        u32x4 o; o.x = (unsigned)f2bf(s[0 * 33]) | ((unsigned)f2bf(s[1 * 33]) << 16); o.y = (unsigned)f2bf(s[2 * 33]) | ((unsigned)f2bf(s[3 * 33]) << 16);
        o.z = (unsigned)f2bf(s[4 * 33]) | ((unsigned)f2bf(s[5 * 33]) << 16); o.w = (unsigned)f2bf(s[6 * 33]) | ((unsigned)f2bf(s[7 * 33]) << 16);
        *(u32x4*)(WT + (size_t)(n0 + nn) * K + k0 + 8 * c) = o; }
    LDS_WAIT(); asm volatile("" ::: "memory");
}

struct Args { const float* in[33]; float* out; unsigned char* ws; int ph_lo, ph_hi; };
constexpr int NPH_LAYER = 10, NPH = 1 + 2 * NPH_LAYER;
#ifndef MK_PER_PHASE
#define MK_PER_PHASE 0
#endif

#define ws (a.ws)
#define in (a.in)
#define out (a.out)
#define ctl ((gu32*)(ws + WS_CTL))
#define XB ((bf16_t*)(ws + WS_XB))
#define XF ((float*)(ws + WS_XF))
#define H ((bf16_t*)(ws + WS_H))
#define YC ((bf16_t*)(ws + WS_YC))
#define PRE ((float*)(ws + WS_PRE))
#define X1F ((float*)(ws + WS_X1F))
#define X1B ((bf16_t*)(ws + WS_X1B))
#define HF ((bf16_t*)(ws + WS_HF))
#define KCS ((float*)(ws + WS_KCS))
#define KCP ((float*)(ws + WS_KCP))
#define SEL ((unsigned long long*)(ws + WS_SEL))
#define OC ((float*)(ws + WS_OC))
#define OS ((float*)(ws + WS_OS))
#define OW ((float*)(ws + WS_OW))
#define YA ((float*)(ws + WS_YA))
#define PL ((float*)(ws + WS_PL))
#define HS ((float*)(ws + WS_HS))
#define pt ((const int*)in[8])
#define IN(k) (lo <= (k) && (k) < hi)
#define SEAM(k) do { if (IN(k) && IN((k) + 1)) xcd_barrier(bar); } while (0)
#define VB_LOOP(NB, CALL) do { const int _nb = (NB); for (int _k = blockIdx.x; 2 * _k < _nb; _k += G) { const int vb = 2 * _k + (tid >> 8), vt = tid & 255; if (vb < _nb) { CALL; } } } while (0)


template <int l>
__device__ __forceinline__ void run_layer(const Args& a, LAS unsigned char* L, const XcdBarrier& bar, const int lo, const int hi, const int tid, const int G) {
        const int p0 = 1 + l * NPH_LAYER;
#define WIN ((const bf16_t*)(ws + WS_WIN) + (size_t)l * NINP * DM)
#define WOUT ((const bf16_t*)(ws + WS_WOUT) + (size_t)l * DM * DM)
#define WUP ((const bf16_t*)(ws + WS_WUP) + (size_t)l * DFF * DM)
#define WDN ((const bf16_t*)(ws + WS_WDN) + (size_t)l * DM * DFF)
#define sp (SsmP{in[10] + l * 2048, in[11] + l * 2048, in[12] + l * 32768, in[13] + l * 32768, in[14] + l * 32768, in[15] + l * 32768, in[16] + l * 512, in[17] + l * 32, in[18] + (size_t)l * 512 * 512, in[19] + l * 512})
#define cp (CpP{in[20] + l * 3 * 512, in[21] + l * 512, in[22] + (size_t)l * 4 * 128 * 128, in[23] + l * 512, in[6] + (size_t)l * 32 * 2 * 512, in[7] + (size_t)l * 32 * 15 * 512})
#define ap (AttP{H, in[2] + (size_t)l * NPOOLPG * 128 * 512, in[3] + (size_t)l * 32 * 512 * 256, pt})
        if (IN(p0 + 0)) {
            pg8::Gemm g{XB, WIN, MP, NINP, DM}; pg8::StaticOrder S; S.init(MP, NINP, G, (int)blockIdx.x);
            pg8::EpiIn E{H, out + O_KVP + (size_t)l * MP * 512, out + O_WINP + (size_t)l * 2 * 512 * 256};
            pg8::gemm_phase<pg8::EpiIn, pg8::StaticOrder, true, true>(L + RING_OFF, g, S, E);
            VB_LOOP((8 * (NINP / 16)) / 4, k_sgemm<0>(vb, vt, XB + (size_t)MP * DM, DM, WIN, NINP, DM, H, nullptr, nullptr, out + O_KVS + (size_t)l * MS * 512, out + O_WINS + (size_t)l * 32 * 512 * 256));
        }
        SEAM(p0 + 0);
        if (IN(p0 + 1)) {
            VB_LOOP((34 * 2048) / 256, k_ssm_scan(vb, vt, sp, H, in[4] + (size_t)l * 32 * 2048, in[5] + (size_t)l * 32 * 2048, HS,
                                                   out + O_SREP + l * 2 * 2048, out + O_SIMP + l * 2 * 2048, out + O_SRES + l * 32 * 2048, out + O_SIMS + l * 32 * 2048));
            VB_LOOP((MT * 512) / 256, k_convpool1(vb, vt, cp, H, YC, PL, out + O_CONVP + l * 2 * 2 * 512, out + O_CONVS + l * 32 * 2 * 512, out + O_POOLP + l * 2 * 15 * 512, out + O_POOLS + l * 32 * 15 * 512));
            VB_LOOP((2 * 64 * 256) / 256, k_compress_prompt(vb, vt, H, in[24] + l * 4096, in[25] + l * 4096, KCP));
            VB_LOOP((32 * 508 * 64 + 255) / 256, k_wincopy(vb, vt, in[3] + (size_t)l * 32 * 512 * 256, out + O_WINS + (size_t)l * 32 * 512 * 256));
            VB_LOOP((MT * 8) / 4, k_attn_naive<1>(vb, vt, ap, SEL, OW));
        }
        SEAM(p0 + 1);
        if (IN(p0 + 2)) {
            VB_LOOP((MT * 512) / 256, k_ssm_y(vb, vt, sp, H, HS, YA));
            VB_LOOP((MT * 512) / 256, k_pool2(vb, vt, cp, PL, YC));
            VB_LOOP((MT * 2) / 4, k_cmp_topk(vb, vt, H, KCP, KCS + (size_t)l * 32 * 128 * 256, OC, SEL));
        }
        SEAM(p0 + 2);
        if (IN(p0 + 3)) {
            VB_LOOP((MT * 512) / 256, k_ssm_glu(vb, vt, sp, YA, YC));
            VB_LOOP((MT * 8) / 4, k_attn_naive<0>(vb, vt, ap, SEL, OS));
        }
        SEAM(p0 + 3);
        if (IN(p0 + 4)) { VB_LOOP((MT * 512) / 256, k_combine(vb, vt, H, OC, OS, OW, YC)); }
        SEAM(p0 + 4);
        if (IN(p0 + 5)) {
            pg8::Gemm g{YC, WOUT, MP, DM, DM}; pg8::StaticOrder S; S.init(MP, DM, G, (int)blockIdx.x);
            pg8::EpiRes E{l == 0 ? in[0] : XF, PRE, ALPHA};
            pg8::gemm_phase<pg8::EpiRes, pg8::StaticOrder, true, true>(L + RING_OFF, g, S, E);
            VB_LOOP((8 * (DM / 16)) / 4, k_sgemm<1>(vb, vt, YC + (size_t)MP * DM, DM, WOUT, DM, DM, nullptr, PRE + (size_t)MP * DM, l == 0 ? in[1] : XF + (size_t)MP * DM, nullptr, nullptr));
        }
        SEAM(p0 + 5);
        if (IN(p0 + 6)) { VB_LOOP(MT / 4, k_ln(vb, vt, PRE, in[27] + l * DM, in[28] + l * DM, X1F, X1F + (size_t)MP * DM, X1B)); }
        SEAM(p0 + 6);
        if (IN(p0 + 7)) {
            pg8::Gemm g{X1B, WUP, MP, DFF, DM}; pg8::StaticOrder S; S.init(MP, DFF, G, (int)blockIdx.x);
            pg8::EpiRelu2 E{HF};
            pg8::gemm_phase<pg8::EpiRelu2, pg8::StaticOrder, true, true>(L + RING_OFF, g, S, E);
            VB_LOOP((8 * (DFF / 16)) / 4, k_sgemm<2>(vb, vt, X1B + (size_t)MP * DM, DM, WUP, DFF, DM, HF, nullptr, nullptr, nullptr, nullptr));
        }
        SEAM(p0 + 7);
        if (IN(p0 + 8)) {
            pg8::Gemm g{HF, WDN, MP, DM, DFF}; pg8::StaticOrder S; S.init(MP, DM, G, (int)blockIdx.x);
            pg8::EpiRes E{X1F, PRE, ALPHA};
            pg8::gemm_phase<pg8::EpiRes, pg8::StaticOrder, true, true>(L + RING_OFF, g, S, E);
            VB_LOOP((8 * (DM / 16)) / 4, k_sgemm<1>(vb, vt, HF + (size_t)MP * DFF, DFF, WDN, DM, DFF, nullptr, PRE + (size_t)MP * DM, X1F + (size_t)MP * DM, nullptr, nullptr));
        }
        SEAM(p0 + 8);
        if (IN(p0 + 9)) {
            if (l == 0) { VB_LOOP(MT / 4, k_ln(vb, vt, PRE, in[31] + l * DM, in[32] + l * DM, XF, XF + (size_t)MP * DM, XB)); }
            else { VB_LOOP(MT / 4, k_ln(vb, vt, PRE, in[31] + l * DM, in[32] + l * DM, out + O_YP, out + O_YS, nullptr)); }
        }
        SEAM(p0 + 9);
    }

__global__ void __launch_bounds__(NWAVES * 64, 2) mk(Args a) {
    extern __shared__ __attribute__((aligned(16))) unsigned char lds[];
    LAS unsigned char* L = (LAS unsigned char*)lds;
    volatile LAS unsigned* MISC = (volatile LAS unsigned*)(L + MISC_OFF);
    const int tid = threadIdx.x, lane = tid & 63, wave = __builtin_amdgcn_readfirstlane(tid >> 6);
    const int G = gridDim.x;
    for (int u = tid; u < (LDS_BYTES - LDSCTL_OFF) / 4; u += NWAVES * 64) ((LAS unsigned*)(L + LDSCTL_OFF))[u] = 0u;
    __syncthreads();
    XcdBarrier bar; bar.bar = (unsigned*)(ctl + CW_BAR); bar.x = 0; bar.st = nullptr;
    if (!MK_PER_PHASE) bar = xcd_barrier_post((unsigned*)(ctl + CW_BAR), MISC + 8);
    const int lo = a.ph_lo, hi = a.ph_hi;
    if (IN(0)) {
        LAS float* scr = (LAS float*)(L + RING_OFF + wave * 16384);
        const int gw = blockIdx.x * NWAVES + wave, NGW = G * NWAVES;
        constexpr int I_IN = (DM / 64) * (NINP / 32), I_OUT = (DM / 64) * (DM / 32), I_UP = (DM / 64) * (DFF / 32), I_DN = (DFF / 64) * (DM / 32), I_L = I_IN + I_OUT + I_UP + I_DN;
        for (int it = gw; it < 2 * I_L; it += NGW) {
            const int l = it / I_L; int r = it % I_L;
            if (r < I_IN) { transpose_item(in[9] + (size_t)l * DM * NIN, DM, NIN, NINP, (bf16_t*)(ws + WS_WIN) + (size_t)l * NINP * DM, scr, r, lane); continue; } r -= I_IN;
            if (r < I_OUT) { transpose_item(in[26] + (size_t)l * DM * DM, DM, DM, DM, (bf16_t*)(ws + WS_WOUT) + (size_t)l * DM * DM, scr, r, lane); continue; } r -= I_OUT;
            if (r < I_UP) { transpose_item(in[29] + (size_t)l * DM * DFF, DM, DFF, DFF, (bf16_t*)(ws + WS_WUP) + (size_t)l * DFF * DM, scr, r, lane); continue; } r -= I_UP;
            transpose_item(in[30] + (size_t)l * DFF * DM, DFF, DM, DM, (bf16_t*)(ws + WS_WDN) + (size_t)l * DM * DFF, scr, r, lane);
        }
        VB_LOOP((MT * DM / 4 + 255) / 256, k_x2bf(vb, vt, in[0], in[1], XB));
        for (int l = 0; l < 2; ++l)
            VB_LOOP((32 * 128 * 256) / 256, k_compress_sample(vb, vt, in[2] + (size_t)l * NPOOLPG * 128 * 512, pt, in[24] + l * 4096, in[25] + l * 4096, KCS + (size_t)l * 32 * 128 * 256));
    }
    SEAM(0);
    run_layer<0>(a, L, bar, lo, hi, tid, G);
    run_layer<1>(a, L, bar, lo, hi, tid, G);
}

#undef IN
#undef SEAM
#undef VB_LOOP
#undef ws
#undef in
#undef out
#undef ctl
#undef XB
#undef XF
#undef H
#undef YC
#undef PRE
#undef X1F
#undef X1B
#undef HF
#undef KCS
#undef KCP
#undef SEL
#undef OC
#undef OS
#undef OW
#undef YA
#undef PL
#undef HS
#undef pt
#undef WIN
#undef WOUT
#undef WUP
#undef WDN
#undef sp
#undef cp
#undef ap

extern "C" void kernel_launch(void* const* d_in, const int* in_sizes, int n_in, void* d_out, int out_size, void* d_ws, size_t ws_size, hipStream_t stream) {
    static int grid = 0;
    if (grid == 0) {
        if (n_in != 33 || (size_t)out_size != O_END || ws_size < WS_END) { fprintf(stderr, "kernel_launch: unexpected sizes n_in %d out %d ws %zu\n", n_in, out_size, ws_size); grid = -1; return; }
        int dev = 0, cus = 0;
        (void)hipGetDevice(&dev); (void)hipDeviceGetAttribute(&cus, hipDeviceAttributeMultiprocessorCount, dev);
        (void)hipFuncSetAttribute((const void*)mk, hipFuncAttributeMaxDynamicSharedMemorySize, LDS_BYTES);
        (void)hipGetLastError();
        grid = cus > 0 ? cus : 256;
    }
    if (grid < 0) return;
    (void)hipMemsetAsync((char*)d_ws + WS_CTL, 0, CTL_ZERO_BYTES, stream);
    Args a{}; for (int i = 0; i < 33; ++i) a.in[i] = (const float*)d_in[i]; a.out = (float*)d_out; a.ws = (unsigned char*)d_ws;
#if MK_PER_PHASE
    for (int p = 0; p < NPH; ++p) { a.ph_lo = p; a.ph_hi = p + 1; hipLaunchKernelGGL(mk, dim3(grid), dim3(NWAVES * 64), LDS_BYTES, stream, a); }
#else
    a.ph_lo = 0; a.ph_hi = NPH; hipLaunchKernelGGL(mk, dim3(grid), dim3(NWAVES * 64), LDS_BYTES, stream, a);
#endif
}
```

```cpp
#include <hip/hip_runtime.h>
#include <cstdio>
#include <cstdint>

constexpr int DM = 2048, TP = 4096, MP = 8192, SBAT = 32, STOK = 4, MS = 128, MT = MP + MS, MPAD = 8448;
constexpr int NIN = 3864, NINP = 4096, DFF = 8192, GW = 512;
constexpr int PAST = 8192, NPOOLPG = 2560, NPG = 64;
constexpr int C_USSM = 0, C_GB = 512, C_GC = 1024, C_VC = 1536, C_UP = 2048, C_Q = 2560, C_KV = 3072, C_GATE = 3840;
constexpr float ALPHA = 1.4142135623730951f;
constexpr float LN_EPS = 1e-5f;
constexpr float NEGF = -1e30f;
constexpr size_t O_YP = 0, O_YS = O_YP + (size_t)MP * DM, O_KVP = O_YS + (size_t)MS * DM, O_KVS = O_KVP + (size_t)2 * MP * 512,
                 O_WINP = O_KVS + (size_t)2 * MS * 512, O_WINS = O_WINP + (size_t)2 * 2 * 512 * 256, O_SREP = O_WINS + (size_t)2 * 32 * 512 * 256,
                 O_SIMP = O_SREP + 2 * 2 * 2048, O_SRES = O_SIMP + 2 * 2 * 2048, O_SIMS = O_SRES + 2 * 32 * 2048, O_CONVP = O_SIMS + 2 * 32 * 2048,
                 O_CONVS = O_CONVP + 2 * 2 * 2 * 512, O_POOLP = O_CONVS + 2 * 32 * 2 * 512, O_POOLS = O_POOLP + 2 * 2 * 15 * 512, O_END = O_POOLS + 2 * 32 * 15 * 512;
static_assert(O_END == 35342336, "output size");
constexpr size_t MiB = 1u << 20;
constexpr size_t WS_CTL = 0, CTL_ZERO_BYTES = 1 * MiB;
constexpr size_t WS_WIN = 2 * MiB;
constexpr size_t WS_WOUT = WS_WIN + 32 * MiB;
constexpr size_t WS_WUP = WS_WOUT + 16 * MiB;
constexpr size_t WS_WDN = WS_WUP + 64 * MiB;
constexpr size_t WS_XB = WS_WDN + 64 * MiB;
constexpr size_t WS_XF = WS_XB + 34 * MiB;
constexpr size_t WS_H = WS_XF + 66 * MiB;
constexpr size_t WS_YC = WS_H + 68 * MiB;
constexpr size_t WS_PRE = WS_YC + 34 * MiB;
constexpr size_t WS_X1F = WS_PRE + 66 * MiB;
constexpr size_t WS_X1B = WS_X1F + 66 * MiB;
constexpr size_t WS_HF = WS_X1B + 34 * MiB;
constexpr size_t WS_KCS = WS_HF + 134 * MiB;
constexpr size_t WS_KCP = WS_KCS + 8 * MiB;
constexpr size_t WS_SEL = WS_KCP + 1 * MiB;
constexpr size_t WS_OC = WS_SEL + 1 * MiB;
constexpr size_t WS_OS = WS_OC + 18 * MiB;
constexpr size_t WS_OW = WS_OS + 18 * MiB;
constexpr size_t WS_YA = WS_OW + 18 * MiB;
constexpr size_t WS_PL = WS_YA + 18 * MiB;
constexpr size_t WS_HS = WS_PL + 18 * MiB;
constexpr size_t WS_OWB = WS_HS + 132 * MiB;
constexpr size_t WS_TT = WS_OWB + 9 * MiB;
constexpr size_t WS_FT = WS_TT + 32 * MiB;
constexpr size_t WS_ET = WS_FT + 8 * MiB;
constexpr size_t WS_GT = WS_ET + 8 * MiB;
constexpr size_t WS_PWT = WS_GT + 1 * MiB;
constexpr size_t WS_SB = WS_PWT + 1 * MiB;
constexpr size_t WS_YAB = WS_SB + 4 * MiB;
constexpr size_t WS_PART = WS_YAB + 9 * MiB;
constexpr size_t WS_YCN = WS_PART + 8 * MiB;
constexpr size_t WS_YAN = WS_YCN + 34 * MiB;
constexpr size_t WS_END = WS_YAN + 9 * MiB;

typedef unsigned short bf16_t;
__host__ __device__ __forceinline__ float bf2f(bf16_t v) { union { unsigned u; float f; } x; x.u = (unsigned)v << 16; return x.f; }
__host__ __device__ __forceinline__ bf16_t f2bf(float f) { union { unsigned u; float f; } x; x.f = f; unsigned u = x.u; return (bf16_t)((u + 0x7fffu + ((u >> 16) & 1u)) >> 16); }

namespace pg8 {
#define PG8_LAS __attribute__((address_space(3)))
typedef unsigned short bf16_t;
typedef short bf16x8 __attribute__((ext_vector_type(8)));
typedef float f32x4 __attribute__((ext_vector_type(4)));
typedef unsigned u32x4 __attribute__((ext_vector_type(4)));
constexpr int BM = 256, BK = 64, HALF = 128, HTB = HALF * BK * 2  , STAGE_BYTES = 8 * HTB, NXCD = 8, WGM = 8;

__host__ __device__ __forceinline__ int lds_byte(int r, int c) { const int st = (r >> 4) * 2 + (c >> 5), rr = r & 15, cc = c & 31, ob = rr * 64 + cc * 2; return st * 1024 + (ob ^ (((ob >> 9) & 1) << 5)); }
__host__ __device__ __forceinline__ void stage_rc(int b, int& R, int& C) { const int st = b / 1024, sb = b % 1024, swz = sb ^ (((sb >> 9) & 1) << 5); R = (st >> 1) * 16 + swz / 64; C = (st & 1) * 32 + (swz % 64) / 2; }
__host__ __device__ __forceinline__ int perm32(int rho) { const int n = rho >> 4, i = rho & 15; return 8 * (i >> 2) + 4 * n + (i & 3); }

struct Unit { int pm, pn; };
struct Gemm { const bf16_t* A; const bf16_t* Bt; int M, N, K; };

struct StaticOrder {
    int nM, nN, nwg, G, c;
    __host__ __device__ void init(int M, int N, int G_, int c_) { nM = M / BM; nN = N / BM; nwg = nM * nN; G = G_; c = c_; }
    __host__ __device__ bool next(int i, Unit& u) const {
        const long L = (long)i * G + c; if (L >= nwg) return false;
        int wgid = (int)L; { const int q = nwg / NXCD, r = nwg % NXCD, xcd = wgid % NXCD, off = wgid / NXCD; wgid = (xcd < r ? xcd * (q + 1) : r * (q + 1) + (xcd - r) * q) + off; }
        const int nig = WGM * nN, gid = wgid / nig, fm = gid * WGM, gsz = (nM - fm) < WGM ? (nM - fm) : WGM;
        u.pm = fm + ((wgid % nig) % gsz); u.pn = (wgid % nig) / gsz; return true;
    }
    __device__ __forceinline__ void a_ready(const Unit&) const {}
    __device__ __forceinline__ void done(const Unit&) const {}
};

__device__ __forceinline__ unsigned cvt_pk_bf16(float lo, float hi) { unsigned r; asm volatile("v_cvt_pk_bf16_f32 %0, %1, %2" : "=v"(r) : "v"(lo), "v"(hi)); return r; }
typedef float f32x2 __attribute__((ext_vector_type(2)));
struct EpiIn {
    static constexpr bool PERM = true, AFTER_DRAIN = false;
    bf16_t* H; float* okv; float* owin;
    __device__ __forceinline__ void operator()(const f32x4 (&acc)[2][2][4][2], const Unit& u, int wr, int wc, int fr, int fq) const {
        const int row0 = u.pm * BM + wr * 64 + fr, col0 = u.pn * BM + wc * 32 + 8 * fq;
#pragma unroll
        for (int ai = 0; ai < 2; ++ai)
#pragma unroll
            for (int m = 0; m < 4; ++m) { const int row = row0 + ai * HALF + m * 16;
#pragma unroll
                for (int bj = 0; bj < 2; ++bj) { const f32x4 v0 = acc[ai][bj][m][0], v1 = acc[ai][bj][m][1]; const int col = col0 + bj * HALF;
                    u32x4 w; w.x = cvt_pk_bf16(v0[0], v0[1]); w.y = cvt_pk_bf16(v0[2], v0[3]); w.z = cvt_pk_bf16(v1[0], v1[1]); w.w = cvt_pk_bf16(v1[2], v1[3]);
                    *(u32x4*)(H + (size_t)row * 4096 + col) = w;
                    if (u.pn == 12 || u.pn == 13) { float* p = okv + (size_t)row * 512 + (col - 3072); *(f32x4*)p = v0; *(f32x4*)(p + 4) = v1; }
                    if (u.pn == 14) { const int t = row & 4095, b = row >> 12; if (t >= 3584) { float* p = owin + ((size_t)(b * 512 + t - 3584) * 256 + (col - 3584)); *(f32x4*)p = v0; *(f32x4*)(p + 4) = v1; } }
                } }
    }
};
struct EpiRes {
    static constexpr bool PERM = true, AFTER_DRAIN = false;
    const float* res; float* pre; float alpha;
    __device__ __forceinline__ void operator()(const f32x4 (&acc)[2][2][4][2], const Unit& u, int wr, int wc, int fr, int fq) const {
        const int row0 = u.pm * BM + wr * 64 + fr, col0 = u.pn * BM + wc * 32 + 8 * fq;
#pragma unroll
        for (int ai = 0; ai < 2; ++ai)
#pragma unroll
            for (int m = 0; m < 4; ++m) { const int row = row0 + ai * HALF + m * 16;
#pragma unroll
                for (int bj = 0; bj < 2; ++bj) { const size_t off = (size_t)row * 2048 + col0 + bj * HALF;
                    const f32x4 r0 = *(const f32x4*)(res + off), r1 = *(const f32x4*)(res + off + 4);
                    *(f32x4*)(pre + off) = r0 * alpha + acc[ai][bj][m][0]; *(f32x4*)(pre + off + 4) = r1 * alpha + acc[ai][bj][m][1]; } }
    }
};
struct EpiRelu2 {
    static constexpr bool PERM = true, AFTER_DRAIN = false;
    bf16_t* O;
    __device__ __forceinline__ void operator()(const f32x4 (&acc)[2][2][4][2], const Unit& u, int wr, int wc, int fr, int fq) const {
        const int row0 = u.pm * BM + wr * 64 + fr, col0 = u.pn * BM + wc * 32 + 8 * fq;
#pragma unroll
        for (int ai = 0; ai < 2; ++ai)
#pragma unroll
            for (int m = 0; m < 4; ++m) { const int row = row0 + ai * HALF + m * 16;
#pragma unroll
                for (int bj = 0; bj < 2; ++bj) { f32x4 v0 = acc[ai][bj][m][0], v1 = acc[ai][bj][m][1];
#pragma unroll
                    for (int e = 0; e < 4; ++e) { const float a = fmaxf(v0[e], 0.f), b = fmaxf(v1[e], 0.f); v0[e] = a * a; v1[e] = b * b; }
                    u32x4 w; w.x = cvt_pk_bf16(v0[0], v0[1]); w.y = cvt_pk_bf16(v0[2], v0[3]); w.z = cvt_pk_bf16(v1[0], v1[1]); w.w = cvt_pk_bf16(v1[2], v1[3]);
                    *(u32x4*)(O + (size_t)row * 8192 + col0 + bj * HALF) = w; } }
    }
};
template <class Epi, class Sched, bool ALIGN_EPI = false, bool SP2 = false>
__device__ __forceinline__ void gemm_phase(PG8_LAS unsigned char* lds, const Gemm g, const Sched& S, const Epi& E) {
    int tid_l = threadIdx.x; asm volatile("" : "+v"(tid_l));
    const int tid = tid_l, wid = __builtin_amdgcn_readfirstlane(tid >> 6), lane = tid & 63, wr = wid >> 2, wc = wid & 3, fr = lane & 15, fq = lane >> 4;
    const int K = g.K, nt = K / BK;
    unsigned voffA[2], voffB[2];
#pragma unroll
    for (int i = 0; i < 2; ++i) { int R, C; stage_rc(tid * 16 + i * 8192, R, C); const int Rb = Epi::PERM ? ((R & ~31) + perm32(R & 31)) : R;
        voffA[i] = (unsigned)(R * K + C) * 2u; voffB[i] = (unsigned)(Rb * K + C) * 2u; }
    const size_t kstep = (size_t)(BK * 2);
    const size_t hstep = (size_t)HALF * K * 2;
    const size_t tstep = 2 * hstep;
    const unsigned ldsw = (unsigned)wid * 1024u;
    const int aoff = lds_byte(wr * 64 + fr, fq * 8), boff = lds_byte(wc * 32 + fr, fq * 8);
#define PG8_SA(b, h) (((b) * 2 + (h)) * HTB)
#define PG8_SB(b, h) ((4 + (b) * 2 + (h)) * HTB)
#define PG8_STAGE(bufoff, gbase, voff) do { _Pragma("unroll") for (int _i = 0; _i < 2; ++_i) \
        __builtin_amdgcn_global_load_lds((const unsigned*)((const char*)(gbase) + (voff)[_i]), (PG8_LAS unsigned*)(lds + (bufoff) + ldsw + _i * 8192), 16, 0, 0); } while (0)
#define PG8_LDA(dst, b, h) do { _Pragma("unroll") for (int m = 0; m < 4; ++m) _Pragma("unroll") for (int k = 0; k < 2; ++k) dst[m][k] = *(const PG8_LAS bf16x8*)(lds + PG8_SA(b, h) + aoff + m * 2048 + k * 1024); } while (0)
#define PG8_LDB(dst, b, h) do { _Pragma("unroll") for (int n = 0; n < 2; ++n) _Pragma("unroll") for (int k = 0; k < 2; ++k) dst[n][k] = *(const PG8_LAS bf16x8*)(lds + PG8_SB(b, h) + boff + n * 2048 + k * 1024); } while (0)
#define PG8_MMA(ai, bj, At, Bt) do { __builtin_amdgcn_s_setprio(1); _Pragma("unroll") for (int m = 0; m < 4; ++m) _Pragma("unroll") for (int n = 0; n < 2; ++n) _Pragma("unroll") for (int k = 0; k < 2; ++k) \
        acc[ai][bj][m][n] = __builtin_amdgcn_mfma_f32_16x16x32_bf16(Bt[n][k], At[m][k], acc[ai][bj][m][n], 0, 0, 0); __builtin_amdgcn_s_setprio(0); } while (0)
#define PG8_WAIT_V(n) asm volatile("s_waitcnt vmcnt(" #n ")" ::: "memory")
#define PG8_WAIT_L(n) asm volatile("s_waitcnt lgkmcnt(" #n ")" ::: "memory")
#define PG8_BAR __builtin_amdgcn_s_barrier()
#define PG8_SCHED __builtin_amdgcn_sched_barrier(0)
    Unit cur, nxt; int ui = 0;
    if (!S.next(0, cur)) return;
    f32x4 acc[2][2][4][2];
#pragma unroll
    for (int a = 0; a < 2; ++a)
#pragma unroll
        for (int b = 0; b < 2; ++b)
#pragma unroll
            for (int m = 0; m < 4; ++m)
#pragma unroll
                for (int n = 0; n < 2; ++n) acc[a][b][m][n] = (f32x4){0.f, 0.f, 0.f, 0.f};
    bf16x8 At[4][2], B0[2][2], B1[2][2];
    const char* cA = (const char*)g.A + (size_t)cur.pm * tstep; const char* cB = (const char*)g.Bt + (size_t)cur.pn * tstep;
    S.a_ready(cur);
    if constexpr (SP2) {
        PG8_STAGE(PG8_SB(0, 0), cB, voffB); PG8_STAGE(PG8_SB(0, 1), cB + hstep, voffB); PG8_STAGE(PG8_SA(0, 0), cA, voffA); PG8_STAGE(PG8_SA(0, 1), cA + hstep, voffA);
        if (wr == 1) PG8_BAR;
        PG8_WAIT_V(2); PG8_BAR;
        PG8_STAGE(PG8_SB(1, 0), cB + kstep, voffB); PG8_STAGE(PG8_SA(1, 0), cA + kstep, voffA); PG8_STAGE(PG8_SB(1, 1), cB + hstep + kstep, voffB);
        PG8_WAIT_V(6); PG8_BAR;
    } else {
        PG8_STAGE(PG8_SB(0, 0), cB, voffB); PG8_STAGE(PG8_SA(0, 0), cA, voffA); PG8_STAGE(PG8_SB(0, 1), cB + hstep, voffB); PG8_STAGE(PG8_SA(0, 1), cA + hstep, voffA);
        if (wr == 1) PG8_BAR;
        PG8_WAIT_V(4); PG8_BAR;
        PG8_STAGE(PG8_SB(1, 0), cB + kstep, voffB); PG8_STAGE(PG8_SA(1, 0), cA + kstep, voffA); PG8_STAGE(PG8_SB(1, 1), cB + hstep + kstep, voffB);
        PG8_WAIT_V(6); PG8_BAR;
    }
    for (;;) {
        const bool has_next = S.next(ui + 1, nxt);
        const char* nA = has_next ? (const char*)g.A + (size_t)nxt.pm * tstep : cA; const char* nB = has_next ? (const char*)g.Bt + (size_t)nxt.pn * tstep : cB;
        for (int t = 0; t < nt; t += 2) {
            const bool last = (t == nt - 2);
            const char* a1 = cA + (size_t)(t + 1) * kstep;
            const char* a2 = last ? nA : cA + (size_t)(t + 2) * kstep; const char* b2 = last ? nB : cB + (size_t)(t + 2) * kstep;
            const char* a3 = a2 + kstep; const char* b3 = b2 + kstep;
            if (last && has_next) S.a_ready(nxt);
            if constexpr (SP2) {
            PG8_LDB(B0, 0, 0); PG8_LDB(B1, 0, 1); PG8_SCHED; PG8_LDA(At, 0, 0); PG8_STAGE(PG8_SA(1, 1), a1 + hstep, voffA);
            PG8_WAIT_V(8); PG8_WAIT_L(0); PG8_BAR; PG8_MMA(0, 0, At, B0); PG8_MMA(0, 1, At, B1); PG8_BAR; PG8_SCHED;
            PG8_LDA(At, 0, 1); PG8_STAGE(PG8_SB(0, 0), b2, voffB); PG8_STAGE(PG8_SB(0, 1), b2 + hstep, voffB); PG8_STAGE(PG8_SA(0, 0), a2, voffA);
            PG8_WAIT_V(8); PG8_WAIT_L(0); PG8_BAR; PG8_MMA(1, 0, At, B0); PG8_MMA(1, 1, At, B1); PG8_BAR; PG8_SCHED;
            PG8_LDB(B0, 1, 0); PG8_LDB(B1, 1, 1); PG8_SCHED; PG8_LDA(At, 1, 0); PG8_STAGE(PG8_SA(0, 1), a2 + hstep, voffA);
            PG8_WAIT_V(8); PG8_WAIT_L(0); PG8_BAR; PG8_MMA(0, 0, At, B0); PG8_MMA(0, 1, At, B1); PG8_BAR; PG8_SCHED;
            PG8_LDA(At, 1, 1); PG8_STAGE(PG8_SB(1, 0), b3, voffB); PG8_STAGE(PG8_SB(1, 1), b3 + hstep, voffB); PG8_STAGE(PG8_SA(1, 0), a3, voffA);
            PG8_WAIT_V(8); PG8_WAIT_L(0); PG8_BAR; PG8_MMA(1, 0, At, B0); PG8_MMA(1, 1, At, B1); PG8_BAR; PG8_SCHED;
            } else {
            PG8_LDB(B0, 0, 0); PG8_SCHED; PG8_LDA(At, 0, 0); PG8_STAGE(PG8_SA(1, 1), a1 + hstep, voffA);
            PG8_WAIT_L(8); PG8_BAR; PG8_WAIT_L(0); PG8_MMA(0, 0, At, B0); PG8_BAR; PG8_SCHED;
            PG8_LDB(B1, 0, 1); PG8_STAGE(PG8_SB(0, 0), b2, voffB);
            PG8_BAR; PG8_WAIT_L(0); PG8_MMA(0, 1, At, B1); PG8_BAR;
            PG8_LDA(At, 0, 1); PG8_STAGE(PG8_SA(0, 0), a2, voffA);
            PG8_BAR; PG8_WAIT_L(0); PG8_MMA(1, 0, At, B0); PG8_BAR; PG8_SCHED;
            PG8_STAGE(PG8_SB(0, 1), b2 + hstep, voffB);
            PG8_WAIT_V(6); PG8_BAR; PG8_MMA(1, 1, At, B1); PG8_BAR;
            PG8_LDB(B0, 1, 0); PG8_SCHED; PG8_LDA(At, 1, 0); PG8_STAGE(PG8_SA(0, 1), a2 + hstep, voffA);
            PG8_WAIT_L(8); PG8_BAR; PG8_WAIT_L(0); PG8_MMA(0, 0, At, B0); PG8_BAR; PG8_SCHED;
            PG8_LDB(B1, 1, 1); PG8_STAGE(PG8_SB(1, 0), b3, voffB);
            PG8_BAR; PG8_WAIT_L(0); PG8_MMA(0, 1, At, B1); PG8_BAR;
            PG8_LDA(At, 1, 1); PG8_STAGE(PG8_SA(1, 0), a3, voffA);
            PG8_BAR; PG8_WAIT_L(0); PG8_MMA(1, 0, At, B0); PG8_BAR; PG8_SCHED;
            PG8_STAGE(PG8_SB(1, 1), b3 + hstep, voffB);
            PG8_WAIT_V(6); PG8_BAR; PG8_MMA(1, 1, At, B1); PG8_BAR;
            }
        }
        if constexpr (ALIGN_EPI) { if (wr == 0) PG8_BAR; }
        if constexpr (!Epi::AFTER_DRAIN) { E(acc, cur, wr, wc, fr, fq); S.done(cur); }
        if (!has_next) break;
#pragma unroll
        for (int a = 0; a < 2; ++a)
#pragma unroll
            for (int b = 0; b < 2; ++b)
#pragma unroll
                for (int m = 0; m < 4; ++m)
#pragma unroll
                    for (int n = 0; n < 2; ++n) acc[a][b][m][n] = (f32x4){0.f, 0.f, 0.f, 0.f};
        cur = nxt; cA = nA; cB = nB; ++ui;
        if constexpr (ALIGN_EPI) { if (wr == 1) PG8_BAR; }
    }
    PG8_WAIT_V(0);
    if constexpr (!ALIGN_EPI) { if (wr == 0) PG8_BAR; }
    PG8_BAR;
    if constexpr (Epi::AFTER_DRAIN) { E.fused(acc, cur, wr, wc, fr, fq, lds, wid, lane); S.done(cur); }
#undef PG8_SA
#undef PG8_SB
#undef PG8_STAGE
#undef PG8_LDA
#undef PG8_LDB
#undef PG8_MMA
#undef PG8_WAIT_V
#undef PG8_WAIT_L
#undef PG8_BAR
#undef PG8_SCHED
}
}
typedef float f32x4 __attribute__((ext_vector_type(4)));
typedef short bf16x8 __attribute__((ext_vector_type(8)));
typedef unsigned u32x4 __attribute__((ext_vector_type(4)));
typedef unsigned u32x2 __attribute__((ext_vector_type(2)));

__device__ __forceinline__ int ltid() { int t = threadIdx.x; asm volatile("" : "+v"(t)); return t; }
__device__ __forceinline__ float wave_sum(float v) {
#pragma unroll
    for (int o = 1; o < 64; o <<= 1) v += __shfl_xor(v, o);
    return v;
}
__device__ __forceinline__ float wave_max(float v) {
#pragma unroll
    for (int o = 1; o < 64; o <<= 1) v = fmaxf(v, __shfl_xor(v, o));
    return v;
}

__device__ __forceinline__ void k_x2bf(const int vb, const int vt, const float* __restrict__ xp, const float* __restrict__ xs, bf16_t* __restrict__ XB) {
    const size_t i = ((size_t)vb * 256 + vt) * 4;
    if (i >= (size_t)MT * DM) return;
    const float* src = (i < (size_t)MP * DM) ? xp + i : xs + (i - (size_t)MP * DM);
    const f32x4 v = *(const f32x4*)src;
    u32x2 w; w.x = (unsigned)f2bf(v[0]) | ((unsigned)f2bf(v[1]) << 16); w.y = (unsigned)f2bf(v[2]) | ((unsigned)f2bf(v[3]) << 16);
    *(u32x2*)(XB + i) = w;
}

template <int MODE>
__device__ __forceinline__ void k_sgemm(const int vb, const int vt, const bf16_t* __restrict__ A, int lda, const bf16_t* __restrict__ Wt, int N, int K,
                                                bf16_t* __restrict__ OB, float* __restrict__ OF, const float* __restrict__ res, float* __restrict__ okv, float* __restrict__ owin) {
    const int wave = (vb * 256 + vt) >> 6, lane = vt & 63;
    const int ntn = N / 16, mt = wave / ntn, nt = wave % ntn;
    if (mt >= 8) return;
    const int fr = lane & 15, fq = lane >> 4;
    const bf16_t* ap = A + (size_t)(mt * 16 + fr) * lda + fq * 8;
    const bf16_t* wp = Wt + (size_t)(nt * 16 + fr) * K + fq * 8;
    f32x4 acc = {0.f, 0.f, 0.f, 0.f};
#pragma unroll 4
    for (int k = 0; k < K; k += 32) {
        const bf16x8 a = *(const bf16x8*)(ap + k), w = *(const bf16x8*)(wp + k);
        acc = __builtin_amdgcn_mfma_f32_16x16x32_bf16(w, a, acc, 0, 0, 0);
    }
    const int m = mt * 16 + fr, n = nt * 16 + fq * 4;
    if (MODE == 0) {
        if (n < NIN) {
            u32x2 w; w.x = (unsigned)f2bf(acc[0]) | ((unsigned)f2bf(acc[1]) << 16); w.y = (unsigned)f2bf(acc[2]) | ((unsigned)f2bf(acc[3]) << 16);
            *(u32x2*)(OB + (size_t)(MP + m) * 4096 + n) = w;
            if (n >= 3072 && n < 3584) *(f32x4*)(okv + (size_t)m * 512 + (n - 3072)) = acc;
            if (n >= 3584 && n < 3840) { const int bs = m >> 2, ts = m & 3; *(f32x4*)(owin + ((size_t)(bs * 512 + 508 + ts) * 256 + (n - 3584))) = acc; }
        }
    } else if (MODE == 1) {
        const size_t off = (size_t)m * 2048 + n; const f32x4 r = *(const f32x4*)(res + off);
        *(f32x4*)(OF + off) = r * ALPHA + acc;
    } else {
        f32x4 v = acc;
#pragma unroll
        for (int e = 0; e < 4; ++e) { const float a = fmaxf(v[e], 0.f); v[e] = a * a; }
        u32x2 w; w.x = (unsigned)f2bf(v[0]) | ((unsigned)f2bf(v[1]) << 16); w.y = (unsigned)f2bf(v[2]) | ((unsigned)f2bf(v[3]) << 16);
        *(u32x2*)(OB + (size_t)(MP + m) * 8192 + n) = w;
    }
}

struct SsmP { const float *a_re, *a_im, *b_re, *b_im, *c_re, *c_im, *d, *log_dt, *w_glu, *b_glu; };
__device__ __forceinline__ void k_ssm_scan(const int vb, const int vt, const int s0, SsmP P, const bf16_t* __restrict__ H, const float* __restrict__ s_re, const float* __restrict__ s_im,
                           float* __restrict__ HS, float* __restrict__ o_rep, float* __restrict__ o_imp, float* __restrict__ o_res, float* __restrict__ o_ims) {
    const int id = vb * 256 + vt;
    if (id >= (34 - s0) * 2048) return;
    const int s = s0 + id / 2048, gn = id % 2048, g = gn / 64;
    const float dt = expf(P.log_dt[g]), are = P.a_re[gn], aim = P.a_im[gn];
    const float mag = expf(dt * are), abr = mag * cosf(dt * aim), abi = mag * sinf(dt * aim);
    const float den = are * are + aim * aim, nr = abr - 1.0f;
    const float fre = (nr * are + abi * aim) / den, fim = (abi * are - nr * aim) / den;
    float bbr[16], bbi[16];
#pragma unroll
    for (int c = 0; c < 16; ++c) { const float br = P.b_re[gn * 16 + c], bi = P.b_im[gn * 16 + c]; bbr[c] = fre * br - fim * bi; bbi[c] = fre * bi + fim * br; }
    float hr = 0.f, hi = 0.f; int T = TP, m0 = s * TP;
    if (s >= 2) { const int bs = s - 2; T = STOK; m0 = MP + bs * STOK; hr = s_re[bs * 2048 + gn]; hi = s_im[bs * 2048 + gn]; }
    for (int t = 0; t < T; ++t) {
        const bf16_t* up = H + (size_t)(m0 + t) * 4096 + C_USSM + g * 16;
        const u32x4 w0 = *(const u32x4*)up, w1 = *(const u32x4*)(up + 8);
        float u[16];
#pragma unroll
        for (int e = 0; e < 4; ++e) { u[2 * e] = __uint_as_float(w0[e] << 16); u[2 * e + 1] = __uint_as_float(w0[e] & 0xffff0000u); u[8 + 2 * e] = __uint_as_float(w1[e] << 16); u[8 + 2 * e + 1] = __uint_as_float(w1[e] & 0xffff0000u); }
        float bur = 0.f, bui = 0.f;
#pragma unroll
        for (int c = 0; c < 16; ++c) { bur += bbr[c] * u[c]; bui += bbi[c] * u[c]; }
        const float nhr = abr * hr - abi * hi + bur, nhi = abr * hi + abi * hr + bui;
        hr = nhr; hi = nhi;
        float* hp = HS + ((size_t)(m0 + t) * 2048 + gn) * 2; hp[0] = hr; hp[1] = hi;
    }
    if (s < 2) { o_rep[s * 2048 + gn] = hr; o_imp[s * 2048 + gn] = hi; } else { o_res[(s - 2) * 2048 + gn] = hr; o_ims[(s - 2) * 2048 + gn] = hi; }
}
__device__ __forceinline__ float gelu_tanh(float x) { const float u = 0.7978845608028654f * (x + 0.044715f * x * x * x); return 0.5f * x * (1.0f + tanhf(u)); }
__device__ __forceinline__ void k_ssm_y(const int vb, const int vt, const int m0, SsmP P, const bf16_t* __restrict__ H, const float* __restrict__ HS, bf16_t* __restrict__ YA) {
    const int id = m0 * 512 + vb * 256 + vt;
    if (id >= MT * 512) return;
    const int m = id / 512, ch = id % 512, g = ch / 16;
    const float* hp = HS + ((size_t)m * 2048 + g * 64) * 2; const float* cr = P.c_re + ch * 64; const float* ci = P.c_im + ch * 64;
    float y = 0.f;
    for (int n = 0; n < 64; ++n) y += cr[n] * hp[2 * n] - ci[n] * hp[2 * n + 1];
    y += P.d[ch] * bf2f(H[(size_t)m * 4096 + C_USSM + ch]);
    YA[id] = f2bf(gelu_tanh(y));
}
struct CpP { const float *conv_w, *conv_b, *pool_w, *pool_scale, *st_conv, *st_pool; };
__device__ __forceinline__ void k_convpool1(const int vb, const int vt, CpP P, const bf16_t* __restrict__ H, bf16_t* __restrict__ YC, float* __restrict__ PL,
                            float* __restrict__ o_convp, float* __restrict__ o_convs, float* __restrict__ o_poolp, float* __restrict__ o_pools, const int mbase) {
    const int id = mbase * 512 + vb * 256 + vt;
    if (id >= MT * 512) return;
    const int m = id / 512, ch = id % 512;
    const bool smp = m >= MP; const int b = smp ? (m - MP) >> 2 : m >> 12, t = smp ? (m - MP) & 3 : m & 4095, T = smp ? STOK : TP, m0 = m - t;
    float e[3];
#pragma unroll
    for (int j = 0; j < 3; ++j) { const int tt = t - 2 + j;
        if (tt >= 0) { const bf16_t* r = H + (size_t)(m0 + tt) * 4096; e[j] = bf2f(r[C_GC + ch]) * bf2f(r[C_VC + ch]); }
        else e[j] = smp ? P.st_conv[(b * 2 + (2 + tt)) * 512 + ch] : 0.f; }
    const float conv = P.conv_b[ch] + P.conv_w[ch] * e[0] + P.conv_w[512 + ch] * e[1] + P.conv_w[1024 + ch] * e[2];
    YC[(size_t)m * 2048 + 512 + ch] = f2bf(bf2f(H[(size_t)m * 4096 + C_GB + ch]) * conv);
    if (t >= T - 2) { if (smp) o_convs[(b * 2 + (t - (T - 2))) * 512 + ch] = e[2]; else o_convp[(b * 2 + (t - (T - 2))) * 512 + ch] = e[2]; }
    const int w = 2 << (ch >> 7); float sum = 0.f;
    for (int s = t - w + 1; s <= t; ++s) { sum += (s >= 0) ? bf2f(H[(size_t)(m0 + s) * 4096 + C_UP + ch]) : (smp ? P.st_pool[(b * 15 + (15 + s)) * 512 + ch] : 0.f); }
    const float ut = bf2f(H[(size_t)m * 4096 + C_UP + ch]);
    const int cnt = min(t + 1 + (smp ? 15 : 0), w);
    PL[id] = sum / (float)cnt - ut;
    if (smp) { o_pools[(b * 15 + 11 + t) * 512 + ch] = ut; if (t == 0) { for (int i = 0; i < 11; ++i) o_pools[(b * 15 + i) * 512 + ch] = P.st_pool[(b * 15 + i + 4) * 512 + ch]; } }
    else if (t >= T - 15) o_poolp[(b * 15 + (t - (T - 15))) * 512 + ch] = ut;
}
__device__ __forceinline__ void k_pool2(const int vb, const int vt, const int m0, CpP P, const float* __restrict__ PL, bf16_t* __restrict__ YC) {
    const int id = m0 * 512 + vb * 256 + vt;
    if (id >= MT * 512) return;
    const int m = id / 512, j = id % 512, gi = j >> 7, dd = j & 127;
    const float* pr = PL + (size_t)m * 512 + gi * 128; const float* w = P.pool_w + (size_t)gi * 128 * 128 + dd;
    float y = 0.f;
    for (int c = 0; c < 128; ++c) y += pr[c] * w[c * 128];
    YC[(size_t)m * 2048 + 1024 + j] = f2bf(y * P.pool_scale[j]);
}

__device__ __forceinline__ void k_compress_prompt(const int vb, const int vt, const bf16_t* __restrict__ H, const float* __restrict__ wck, const float* __restrict__ wcv, float* __restrict__ KCP) {
    const int id = vb * 256 + vt;
    if (id >= 2 * 64 * 256) return;
    const int gd = id & 127, kv = (id >> 7) & 1, j = (id >> 8) & 63, b = id >> 14, d = gd & 63;
    const float* w = kv ? wcv : wck; float s = 0.f;
    for (int k = 0; k < 64; ++k) s += bf2f(H[(size_t)(b * TP + j * 64 + k) * 4096 + C_KV + kv * 128 + gd]) * w[k * 64 + d];
    KCP[id] = s;
}
__device__ __forceinline__ void k_compress_sample(const int vb, const int vt, const float* __restrict__ cache  , const int* __restrict__ pt, const float* __restrict__ wck, const float* __restrict__ wcv, float* __restrict__ KCS) {
    const int id = vb * 256 + vt;
    if (id >= 32 * 128 * 256) return;
    const int gd = id & 127, kv = (id >> 7) & 1, j = (id >> 8) & 127, bs = id >> 15, d = gd & 63;
    const float* w = kv ? wcv : wck;
    const int page = pt[bs * NPG + (j >> 1)];
    const float* base = cache + ((size_t)page * 128 + (j & 1) * 64) * 512 + kv * 128 + gd;
    float s = 0.f;
    for (int k = 0; k < 64; ++k) s += base[(size_t)k * 512] * w[k * 64 + d];
    KCS[id] = s;
}
__device__ __forceinline__ void k_cmp_topk(const int vb, const int vt, const int m0, const bf16_t* __restrict__ H, const float* __restrict__ KCP, const float* __restrict__ KCS,
                                                   float* __restrict__ OC, unsigned long long* __restrict__ SEL) {
    const int wv = (vb * 256 + vt) >> 6, lane = vt & 63;
    if (wv >= (MT - m0) * 2) return;
    const int m = m0 + (wv >> 1), g = wv & 1;
    const bool smp = m >= MP; const int b = smp ? (m - MP) >> 2 : m >> 12, t = smp ? (m - MP) & 3 : m & 4095;
    const int pos = smp ? PAST + t : t, cur = pos >> 6;
    const float* kc0; const float* kc1; bool ex1 = smp;
    if (smp) { kc0 = KCS + ((size_t)(b * 128 + lane) * 2) * 128 + g * 64; kc1 = KCS + ((size_t)(b * 128 + lane + 64) * 2) * 128 + g * 64; }
    else { kc0 = KCP + ((size_t)(b * 64 + lane) * 2) * 128 + g * 64; kc1 = kc0; }
    const bool cp0 = (64 * lane + 63 <= pos), cp1 = ex1 && (64 * (lane + 64) + 63 <= pos);
    float imp0 = 0.f, imp1 = 0.f;
    for (int r = 0; r < 4; ++r) {
        const bf16_t* q = H + (size_t)m * 4096 + C_Q + (g * 4 + r) * 64;
        float s0 = 0.f, s1 = 0.f;
        for (int d = 0; d < 64; ++d) { const float qv = bf2f(q[d]); s0 += qv * kc0[d]; s1 += qv * kc1[d]; }
        s0 = cp0 ? s0 * 0.125f : NEGF; s1 = cp1 ? s1 * 0.125f : NEGF;
        const float mx = wave_max(fmaxf(s0, s1));
        const float e0 = cp0 ? expf(s0 - mx) : 0.f, e1 = cp1 ? expf(s1 - mx) : 0.f;
        const float sum = wave_sum(e0 + e1), inv = sum > 0.f ? 1.0f / sum : 0.f;
        const float p0 = e0 * inv, p1 = e1 * inv;
        imp0 += p0; imp1 += p1;
        float o = 0.f;
        for (int d = 0; d < 64; ++d) { const float v = wave_sum(p0 * kc0[128 + d] + (ex1 ? p1 * kc1[128 + d] : 0.f)); if (lane == d) o = v; }
        OC[(size_t)m * 512 + (g * 4 + r) * 64 + lane] = o;
    }
    const int j0 = lane, j1 = lane + 64;
    const float sc0 = (j0 == 0 || j0 == cur || j0 == cur - 1) ? 5.0f : ((64 * j0 <= pos) ? imp0 : -1.0f);
    const float sc1 = (j1 == 0 || j1 == cur || j1 == cur - 1) ? 5.0f : ((64 * j1 <= pos) ? imp1 : -1.0f);
    int rk0 = 0, rk1 = 0;
    for (int jp = 0; jp < 64; ++jp) {
        const float a = __shfl(sc0, jp);
        rk0 += (a > sc0 || (a == sc0 && jp < j0)) ? 1 : 0;
        if (smp) { rk1 += (a > sc1 || (a == sc1 && jp < j1)) ? 1 : 0;
            const float c = __shfl(sc1, jp); const int jq = jp + 64;
            rk0 += (c > sc0 || (c == sc0 && jq < j0)) ? 1 : 0; rk1 += (c > sc1 || (c == sc1 && jq < j1)) ? 1 : 0; }
    }
    if (smp) { rk0 += (5.0f > sc0) ? 1 : 0; rk1 += (5.0f > sc1) ? 1 : 0; }
    const unsigned long long bm0 = __ballot(rk0 < 16), bm1 = smp ? __ballot(rk1 < 16) : 0ull;
    if (lane == 0) { unsigned long long* sp = SEL + (size_t)(m * 2 + g) * 3; sp[0] = bm0; sp[1] = bm1; sp[2] = smp ? 1ull : 0ull; }
}
struct AttP { const bf16_t* H; const float* cache; const float* wcache; const int* pt; };
__device__ __forceinline__ float kv_elem(const AttP& A, bool smp, int b, int g, int slot, int kp, int d) {
    if (!smp) return bf2f(A.H[(size_t)(b * TP + kp) * 4096 + C_KV + slot * 128 + g * 64 + d]);
    if (kp >= PAST) return bf2f(A.H[(size_t)(MP + b * STOK + (kp - PAST)) * 4096 + C_KV + slot * 128 + g * 64 + d]);
    if (slot < 4) { const int page = A.pt[b * NPG + (kp >> 7)]; return A.cache[((size_t)page * 128 + (kp & 127)) * 512 + slot * 128 + g * 64 + d]; }
    return A.wcache[((size_t)b * 512 + (kp - (PAST - 512))) * 256 + (slot - 4) * 128 + g * 64 + d];
}
template <int BR>
__device__ __forceinline__ void k_attn_naive(const int vb, const int vt, const int m0, AttP A, const unsigned long long* __restrict__ SEL, float* __restrict__ O) {
    const int wv = (vb * 256 + vt) >> 6, lane = vt & 63;
    if (wv >= (MT - m0) * 8) return;
    const int m = m0 + (wv >> 3), h = wv & 7, g = h >> 2;
    const bool smp = m >= MP; const int b = smp ? (m - MP) >> 2 : m >> 12, t = smp ? (m - MP) & 3 : m & 4095;
    const int pos = smp ? PAST + t : t;
    const bf16_t* qp = A.H + (size_t)m * 4096 + C_Q + h * 64;
    unsigned long long mk0 = 0, mk1 = 0, mk2 = 0;
    if (BR == 0) { const unsigned long long* sp = SEL + (size_t)(m * 2 + g) * 3; mk0 = sp[0]; mk1 = sp[1]; mk2 = sp[2]; }
    float mrun = NEGF, l = 0.f, o = 0.f;
    const int nchunk = BR == 0 ? 16 : 8;
    for (int c = 0; c < nchunk; ++c) {
        int kp0;
        if (BR == 0) { int kb; if (mk0) { kb = __builtin_ctzll(mk0); mk0 &= mk0 - 1; } else if (mk1) { kb = 64 + __builtin_ctzll(mk1); mk1 &= mk1 - 1; } else if (mk2) { kb = 128; mk2 = 0; } else break; kp0 = kb * 64; }
        else kp0 = pos - 511 + 64 * c;
        const int kp = kp0 + lane;
        const bool valid = (kp >= 0) && (kp <= pos);
        float s = NEGF;
        if (valid) { float a = 0.f;
#pragma unroll 4
            for (int d = 0; d < 64; ++d) a += bf2f(qp[d]) * kv_elem(A, smp, b, g, BR == 0 ? 2 : 4, kp, d);
            s = a * 0.125f; }
        const float bm = wave_max(s), mnew = fmaxf(mrun, bm), alpha = expf(mrun - mnew);
        const float e = valid ? expf(s - mnew) : 0.f;
        l = l * alpha + wave_sum(e); o *= alpha; mrun = mnew;
        for (int k = 0; k < 64; ++k) { const float ek = __shfl(e, k); if (ek != 0.f) o += ek * kv_elem(A, smp, b, g, BR == 0 ? 3 : 5, kp0 + k, lane); }
    }
    O[(size_t)m * 512 + h * 64 + lane] = o / l;
}
__device__ __forceinline__ void k_combine(const int vb, const int vt, const int m0, const bf16_t* __restrict__ H, const float* __restrict__ OC, const float* __restrict__ OS, const float* __restrict__ OW, bf16_t* __restrict__ YC) {
    const int id = m0 * 512 + vb * 256 + vt;
    if (id >= MT * 512) return;
    const int m = id / 512, hd = id % 512, h = hd >> 6;
    const bf16_t* gp = H + (size_t)m * 4096 + C_GATE + h * 3;
    const float g0 = 1.f / (1.f + expf(-bf2f(gp[0]))), g1 = 1.f / (1.f + expf(-bf2f(gp[1]))), g2 = 1.f / (1.f + expf(-bf2f(gp[2])));
    YC[(size_t)m * 2048 + 1536 + hd] = f2bf(g0 * OC[id] + g1 * OS[id] + g2 * OW[id]);
}
__device__ __forceinline__ void k_wincopy(const int vb, const int vt, const float* __restrict__ wcache, float* __restrict__ owin) {
    const size_t id = (size_t)vb * 256 + vt;
    if (id >= (size_t)32 * 508 * 64) return;
    const int bs = (int)(id / (508 * 64)); const size_t r = id % (508 * 64);
    *(f32x4*)(owin + (size_t)bs * 512 * 256 + r * 4) = *(const f32x4*)(wcache + (size_t)bs * 512 * 256 + 4 * 256 + r * 4);
}
__device__ __forceinline__ void k_ln(const int vb, const int vt, const float* __restrict__ PRE, const float* __restrict__ gam, const float* __restrict__ bet,
                                             float* __restrict__ outFp, float* __restrict__ outFs, bf16_t* __restrict__ outB, const float* __restrict__ part = nullptr, const float* __restrict__ pres = nullptr) {
    const int m = (vb * 256 + vt) >> 6, lane = vt & 63;
    if (m >= MT) return;
    const float* pr = PRE + (size_t)m * DM;
    f32x4 v[8]; float s = 0.f;
#pragma unroll
    for (int j = 0; j < 8; ++j) {
        if (part && m >= MP) {
            const size_t o = (size_t)(m - MP) * DM + j * 256 + lane * 4; f32x4 a = *(const f32x4*)(pres + o) * ALPHA;
#pragma unroll
            for (int sl = 0; sl < 8; ++sl) a += *(const f32x4*)(part + (size_t)sl * MS * DM + o);
            v[j] = a;
        } else v[j] = *(const f32x4*)(pr + j * 256 + lane * 4);
        s += (v[j][0] + v[j][1]) + (v[j][2] + v[j][3]); }
    const float mean = wave_sum(s) * (1.0f / DM); float s2 = 0.f;
#pragma unroll
    for (int j = 0; j < 8; ++j) { v[j] = v[j] - mean; s2 += (v[j][0] * v[j][0] + v[j][1] * v[j][1]) + (v[j][2] * v[j][2] + v[j][3] * v[j][3]); }
    const float rstd = 1.0f / sqrtf(wave_sum(s2) * (1.0f / DM) + LN_EPS);
    float* of = (m < MP) ? outFp + (size_t)m * DM : outFs + (size_t)(m - MP) * DM;
#pragma unroll
    for (int j = 0; j < 8; ++j) { const int c = j * 256 + lane * 4; const f32x4 gg = *(const f32x4*)(gam + c), bb = *(const f32x4*)(bet + c);
        const f32x4 y = v[j] * rstd * gg + bb; *(f32x4*)(of + c) = y;
        if (outB) { u32x2 w; w.x = (unsigned)f2bf(y[0]) | ((unsigned)f2bf(y[1]) << 16); w.y = (unsigned)f2bf(y[2]) | ((unsigned)f2bf(y[3]) << 16); *(u32x2*)(outB + (size_t)m * DM + c) = w; } }
}
constexpr int NWAVES = 8;
constexpr int RING_OFF = 0, RING_BYTES = 151552;
constexpr int LDSCTL_OFF = RING_BYTES, MISC_OFF = LDSCTL_OFF + 320;
constexpr int LDS_BYTES = 155648;
constexpr int CW_TMO = 0, CW_BAR = 4096;
#define GAS __attribute__((address_space(1)))
#define LAS __attribute__((address_space(3)))
typedef GAS unsigned gu32;
#define RLX_AGENT __ATOMIC_RELAXED, __HIP_MEMORY_SCOPE_AGENT
#define LDS_WAIT() asm volatile("s_waitcnt lgkmcnt(0)" ::: "memory")
#define VM_WAIT() asm volatile("s_waitcnt vmcnt(0)" ::: "memory")
#define XB_TMO      128
#define XB_XCNT(j)  (256  + 64 * (j))
#define XB_XSUB(j)  (1280 + 64 * (j))
#define XB_XGEN(j)  (2304 + 64 * (j))
#define XB_TOP      3328
#define XB_TOPGEN   3392
#define XCD_BAR_WORDS 3456
#define XB_SPIN_CAP (1u << 18)

__device__ __forceinline__ unsigned xb_ld(unsigned* p)              { return __hip_atomic_load(p, __ATOMIC_RELAXED, __HIP_MEMORY_SCOPE_AGENT); }
__device__ __forceinline__ unsigned xb_add(unsigned* p, unsigned v) { return __hip_atomic_fetch_add(p, v, __ATOMIC_RELAXED, __HIP_MEMORY_SCOPE_AGENT); }
__device__ __forceinline__ unsigned xb_xcc_id() { return (unsigned)__builtin_amdgcn_s_getreg((3 << 11) | 20) & 0xFu; }
#define XB_SPIN(cond, bar) do { unsigned _sp = 0; while (cond) { __builtin_amdgcn_s_sleep(1); \
    if ((++_sp & 255u) == 0u) { if (xb_ld(&(bar)[XB_TMO])) break; if (_sp > XB_SPIN_CAP) { atomicAdd(&(bar)[XB_TMO], 1u); break; } } } } while (0)

struct XcdBarrier {
    unsigned* bar; unsigned x;
    volatile LAS unsigned* st;
};

__device__ __forceinline__ XcdBarrier xcd_barrier_post(unsigned* bar, volatile LAS unsigned* st) {
    XcdBarrier b; b.bar = bar; b.x = xb_xcc_id(); b.st = st;
    if (threadIdx.x == 0) (void)xb_add(&bar[XB_XCNT(b.x)], 1u);
    return b;
}
__device__ __forceinline__ void xcd_barrier_complete(unsigned* bar, unsigned x, unsigned& nloc, unsigned& nx) {
    const unsigned G = gridDim.x * gridDim.y * gridDim.z;
    unsigned sum, cnt, mine, sp = 0u;
    for (;;) {
        sum = 0u; cnt = 0u; mine = 0u;
#pragma unroll
        for (unsigned j = 0; j < 16; ++j) { const unsigned c = xb_ld(&bar[XB_XCNT(j)]); sum += c; cnt += (c > 0u) ? 1u : 0u; mine = (j == x) ? c : mine; }
        if (sum == G) break;
        __builtin_amdgcn_s_sleep(1);
        if ((++sp & 255u) == 0u) { if (xb_ld(&bar[XB_TMO])) break; if (sp > XB_SPIN_CAP) { atomicAdd(&bar[XB_TMO], 1u); break; } }
    }
    nloc = mine > 0u ? mine : 1u; nx = cnt > 0u ? cnt : 1u;
}

__device__ __forceinline__ void xcd_barrier(const XcdBarrier& b) {
    asm volatile("s_waitcnt vmcnt(0)" ::: "memory");
    __syncthreads();
    if (threadIdx.x == 0) {
        unsigned* bar = b.bar;
        __builtin_amdgcn_s_waitcnt(0);
        unsigned nloc = b.st[0], nx = b.st[1];
        if (nloc == 0u) { xcd_barrier_complete(bar, b.x, nloc, nx); b.st[0] = nloc; b.st[1] = nx; }
        const unsigned old = xb_add(&bar[XB_XSUB(b.x)], 1u);
        const unsigned gen = old / nloc;
        if (old + 1u == (gen + 1u) * nloc) {
            __builtin_amdgcn_fence(__ATOMIC_RELEASE, "agent");
            asm volatile("s_waitcnt vmcnt(0)" ::: "memory");
            const unsigned og = xb_add(&bar[XB_TOP], 1u);
            const unsigned tg = og / nx;
            if (og + 1u == (tg + 1u) * nx) xb_add(&bar[XB_TOPGEN], 1u);
            else XB_SPIN(xb_ld(&bar[XB_TOPGEN]) == tg, bar);
            __builtin_amdgcn_fence(__ATOMIC_ACQUIRE, "agent");
            xb_add(&bar[XB_XGEN(b.x)], 1u);
            asm volatile("s_waitcnt vmcnt(0)" ::: "memory");
        } else {
            XB_SPIN(xb_ld(&bar[XB_XGEN(b.x)]) == gen, bar);
            __builtin_amdgcn_fence(__ATOMIC_ACQUIRE, "agent");
            asm volatile("s_waitcnt vmcnt(0)" ::: "memory");
        }
    }
    __syncthreads();
}

namespace att {
typedef float f32x16 __attribute__((ext_vector_type(16)));
constexpr int KS_B = 144, VS_B = 136;
constexpr int KT_BYTES = 64 * KS_B, VT_BYTES = 64 * VS_B, BUF_BYTES = 18432;
constexpr int OFF_BUF0 = 0, OFF_BUF1 = BUF_BYTES, OFF_IMP = 2 * BUF_BYTES, IMP_PITCH = 65, OFF_SM = OFF_IMP + 64 * IMP_PITCH * 4, OFF_UNI = OFF_SM + 512, OFF_Q = OFF_UNI + 64, ATT_LDS = OFF_Q + 64;
static_assert(KT_BYTES + VT_BYTES <= BUF_BYTES && OFF_SM % 8 == 0 && ATT_LDS <= RING_BYTES, "attention LDS map");
constexpr float C2 = 0.125f * 1.4426950408889634f;

struct KVRegs { u32x4 k, v; };
__device__ __forceinline__ void kv_load(KVRegs& R, const bf16_t* Hb, int kb, int kcol, int vcol, int tid) {
    const int key = tid >> 3, ch = tid & 7; const bf16_t* row = Hb + (size_t)(kb * 64 + key) * 4096;
    R.k = *(const u32x4*)(row + kcol + ch * 8); R.v = *(const u32x4*)(row + vcol + ch * 8);
}
__device__ __forceinline__ void kv_store(const KVRegs& R, LAS unsigned char* buf, int tid) {
    const int key = tid >> 3, ch = tid & 7;
    *(LAS u32x4*)(buf + key * KS_B + ch * 16) = R.k;
    LAS unsigned short* vt = (LAS unsigned short*)(buf + KT_BYTES) + (ch * 8) * (VS_B / 2) + key;
#pragma unroll
    for (int e = 0; e < 8; ++e) vt[e * (VS_B / 2)] = (unsigned short)((e & 1) ? (R.v[e >> 1] >> 16) : (R.v[e >> 1] & 0xffffu));
}
__device__ __forceinline__ unsigned pk_bf16(float lo, float hi) { unsigned r; asm volatile("v_cvt_pk_bf16_f32 %0, %1, %2" : "=v"(r) : "v"(lo), "v"(hi)); return r; }
__device__ __forceinline__ void mask_le(f32x16& p0, f32x16& p1, int limh) {
#pragma unroll
    for (int r = 0; r < 16; ++r) { const int c = (r & 3) + 8 * (r >> 2); if (c > limh) p0[r] = NEGF; if (c + 32 > limh) p1[r] = NEGF; }
}
__device__ __forceinline__ void mask_gt(f32x16& p0, f32x16& p1, int limh) {
#pragma unroll
    for (int r = 0; r < 16; ++r) { const int c = (r & 3) + 8 * (r >> 2); if (c <= limh) p0[r] = NEGF; if (c + 32 <= limh) p1[r] = NEGF; }
}
__device__ __forceinline__ void qk_step(LAS const unsigned char* buf, const bf16x8 (&qf)[4], f32x16& p0, f32x16& p1, int ql, int hi) {
    p0 = (f32x16){0.f}; p1 = (f32x16){0.f};
#pragma unroll
    for (int ks = 0; ks < 4; ++ks) {
        const bf16x8 k0 = *(LAS const bf16x8*)(buf + ql * KS_B + (16 * ks + 8 * hi) * 2);
        const bf16x8 k1 = *(LAS const bf16x8*)(buf + (32 + ql) * KS_B + (16 * ks + 8 * hi) * 2);
        p0 = __builtin_amdgcn_mfma_f32_32x32x16_bf16(k0, qf[ks], p0, 0, 0, 0);
        p1 = __builtin_amdgcn_mfma_f32_32x32x16_bf16(k1, qf[ks], p1, 0, 0, 0);
    }
}
__device__ __forceinline__ float max3f(float a, float b, float c) { return __builtin_fmaxf(__builtin_fmaxf(a, b), c); }
__device__ __forceinline__ void softmax_step(f32x16& p0, f32x16& p1, f32x16 (&o)[2], float& m_run, float& l_run) {
    float ba = max3f(p0[0], p0[1], p1[0]), bb = max3f(p0[2], p0[3], p1[1]); ba = max3f(ba, p1[2], p1[3]);
#pragma unroll
    for (int r = 4; r < 16; r += 4) { ba = max3f(ba, p0[r], p0[r + 1]); bb = max3f(bb, p0[r + 2], p0[r + 3]); ba = max3f(ba, p1[r], p1[r + 1]); bb = max3f(bb, p1[r + 2], p1[r + 3]); }
    float bm = __builtin_fmaxf(ba, bb); bm = __builtin_fmaxf(bm, __shfl_xor(bm, 32)) * C2;
    if (__any(bm > m_run + 8.0f)) {
        const float mn = max3f(m_run, bm, -1e20f), alpha = __builtin_amdgcn_exp2f(m_run - mn);
        l_run *= alpha; m_run = mn;
#pragma unroll
        for (int r = 0; r < 16; ++r) { o[0][r] *= alpha; o[1][r] *= alpha; }
    }
    const float nm = -m_run; float ls0 = 0.f, ls1 = 0.f;
#pragma unroll
    for (int r = 0; r < 16; ++r) { p0[r] = __builtin_amdgcn_exp2f(__builtin_fmaf(p0[r], C2, nm)); p1[r] = __builtin_amdgcn_exp2f(__builtin_fmaf(p1[r], C2, nm)); ls0 += p0[r]; ls1 += p1[r]; }
    l_run += ls0 + ls1;
}
__device__ __forceinline__ void pv_step(LAS const unsigned char* buf, const f32x16& p0, const f32x16& p1, f32x16 (&o)[2], int ql, int hi) {
#pragma unroll
    for (int kt = 0; kt < 2; ++kt)
#pragma unroll
        for (int s = 0; s < 2; ++s) {
            const f32x16& p = kt ? p1 : p0;
            u32x4 pw; pw.x = pk_bf16(p[8 * s + 0], p[8 * s + 1]); pw.y = pk_bf16(p[8 * s + 2], p[8 * s + 3]); pw.z = pk_bf16(p[8 * s + 4], p[8 * s + 5]); pw.w = pk_bf16(p[8 * s + 6], p[8 * s + 7]);
            const bf16x8 pf = __builtin_bit_cast(bf16x8, pw);
#pragma unroll
            for (int dt = 0; dt < 2; ++dt) {
                LAS const unsigned char* vrow = buf + KT_BYTES + (32 * dt + ql) * VS_B + (32 * kt + 16 * s + 4 * hi) * 2;
                const u32x2 lo = *(LAS const u32x2*)vrow, h8 = *(LAS const u32x2*)(vrow + 16);
                u32x4 vw; vw.x = lo.x; vw.y = lo.y; vw.z = h8.x; vw.w = h8.y;
                o[dt] = __builtin_amdgcn_mfma_f32_32x32x16_bf16(__builtin_bit_cast(bf16x8, vw), pf, o[dt], 0, 0, 0);
            }
        }
}
__device__ __forceinline__ void load_q(bf16x8 (&qf)[4], const bf16_t* H, int row, int h, int hi) {
    const bf16_t* qp = H + (size_t)row * 4096 + C_Q + h * 64 + 8 * hi;
#pragma unroll
    for (int ks = 0; ks < 4; ++ks) qf[ks] = *(const bf16x8*)(qp + 16 * ks);
}

__device__ __forceinline__ void window_unit(LAS unsigned char* L, const bf16_t* __restrict__ H, bf16_t* __restrict__ OWB, int b, int g, int i) {
    const int tid = ltid(), lane = tid & 63, w = __builtin_amdgcn_readfirstlane(tid >> 6), ql = lane & 31, hi = lane >> 5;
    const int h = 4 * g + (w & 3), tq = 32 * (w >> 2) + ql, row = b * TP + 64 * i + tq;
    const bf16_t* Hb = H + (size_t)b * TP * 4096;
    const int kcol = C_KV + 4 * 128 + g * 64, vcol = C_KV + 5 * 128 + g * 64;
    bf16x8 qf[4]; load_q(qf, H, row, h, hi);
    f32x16 o[2]; o[0] = (f32x16){0.f}; o[1] = (f32x16){0.f};
    float m_run = NEGF, l_run = 0.f;
    const int kb0 = i >= 8 ? i - 8 : 0;
    KVRegs R; kv_load(R, Hb, kb0, kcol, vcol, tid);
    __syncthreads();
    kv_store(R, L + OFF_BUF0, tid);
    __syncthreads();
    int cur = 0;
    for (int kb = kb0; kb <= i; ++kb) {
        if (kb < i) kv_load(R, Hb, kb + 1, kcol, vcol, tid);
        LAS const unsigned char* buf = L + (cur ? OFF_BUF1 : OFF_BUF0);
        f32x16 p0, p1; qk_step(buf, qf, p0, p1, ql, hi);
        if (kb == i) mask_le(p0, p1, tq - 4 * hi);
        else if (kb == i - 8) mask_gt(p0, p1, tq - 4 * hi);
        softmax_step(p0, p1, o, m_run, l_run);
        pv_step(buf, p0, p1, o, ql, hi);
        if (kb < i) kv_store(R, L + (cur ? OFF_BUF0 : OFF_BUF1), tid);
        __syncthreads();
        cur ^= 1;
    }
    l_run += __shfl_xor(l_run, 32);
    const float inv = 1.0f / l_run;
    bf16_t* op = OWB + (size_t)row * 512 + h * 64 + 4 * hi;
#pragma unroll
    for (int dt = 0; dt < 2; ++dt)
#pragma unroll
        for (int rr = 0; rr < 4; ++rr) { u32x2 wv; wv.x = pk_bf16(o[dt][4 * rr] * inv, o[dt][4 * rr + 1] * inv); wv.y = pk_bf16(o[dt][4 * rr + 2] * inv, o[dt][4 * rr + 3] * inv);
            *(u32x2*)(op + 32 * dt + 8 * rr) = wv; }
}

__device__ __forceinline__ void nsa_unit(LAS unsigned char* L, const bf16_t* __restrict__ H, const float* __restrict__ KCP, const bf16_t* __restrict__ OWB, bf16_t* __restrict__ YC, int b, int g, int i) {
    const int tid = ltid(), lane = tid & 63, w = __builtin_amdgcn_readfirstlane(tid >> 6), ql = lane & 31, hi = lane >> 5;
    const int h = 4 * g + (w & 3), tq = 32 * (w >> 2) + ql, row = b * TP + 64 * i + tq;
    const bf16_t* Hb = H + (size_t)b * TP * 4096;
    LAS float* imp = (LAS float*)(L + OFF_IMP); LAS unsigned long long* smk = (LAS unsigned long long*)(L + OFF_SM); LAS unsigned long long* uni = (LAS unsigned long long*)(L + OFF_UNI);
    bf16x8 qf[4]; load_q(qf, H, row, h, hi);
    float g0, g1, g2;
    { const bf16_t* gp = H + (size_t)row * 4096 + C_GATE + h * 3; g0 = 1.f / (1.f + __expf(-bf2f(gp[0]))); g1 = 1.f / (1.f + __expf(-bf2f(gp[1]))); g2 = 1.f / (1.f + __expf(-bf2f(gp[2]))); }
    __syncthreads();
    { const int key = tid >> 3, ch = tid & 7; const float* kp = KCP + ((size_t)(b * 64 + key) * 2) * 128 + g * 64 + ch * 8;
      const f32x4 a0 = *(const f32x4*)kp, a1 = *(const f32x4*)(kp + 4), v0 = *(const f32x4*)(kp + 128), v1 = *(const f32x4*)(kp + 132);
      KVRegs R; R.k.x = pk_bf16(a0[0], a0[1]); R.k.y = pk_bf16(a0[2], a0[3]); R.k.z = pk_bf16(a1[0], a1[1]); R.k.w = pk_bf16(a1[2], a1[3]);
      R.v.x = pk_bf16(v0[0], v0[1]); R.v.y = pk_bf16(v0[2], v0[3]); R.v.z = pk_bf16(v1[0], v1[1]); R.v.w = pk_bf16(v1[2], v1[3]);
      kv_store(R, L + OFF_BUF0, tid);
      for (int e = tid; e < 64 * IMP_PITCH; e += 512) imp[e] = 0.f; }
    __syncthreads();
    f32x16 acc[2];
    {
        f32x16 p0, p1, o[2]; o[0] = (f32x16){0.f}; o[1] = (f32x16){0.f}; float m_run = NEGF, l_run = 0.f;
        qk_step(L + OFF_BUF0, qf, p0, p1, ql, hi);
        mask_le(p0, p1, ((tq == 63) ? i : i - 1) - 4 * hi);
        softmax_step(p0, p1, o, m_run, l_run);
        l_run += __shfl_xor(l_run, 32);
        const float inv = l_run > 0.f ? 1.0f / l_run : 0.f;
        pv_step(L + OFF_BUF0, p0, p1, o, ql, hi);
#pragma unroll
        for (int r = 0; r < 16; ++r) { acc[0][r] = o[0][r] * (inv * g0); acc[1][r] = o[1][r] * (inv * g0); }
#pragma unroll
        for (int r = 0; r < 16; ++r) { const int c = (r & 3) + 8 * (r >> 2) + 4 * hi;
            __hip_atomic_fetch_add(imp + c * IMP_PITCH + tq, p0[r] * inv, __ATOMIC_RELAXED, __HIP_MEMORY_SCOPE_WORKGROUP);
            __hip_atomic_fetch_add(imp + (c + 32) * IMP_PITCH + tq, p1[r] * inv, __ATOMIC_RELAXED, __HIP_MEMORY_SCOPE_WORKGROUP); }
    }
    __syncthreads();
    { unsigned long long wu = 0ull;
      for (int tt = 0; tt < 8; ++tt) { const int t8 = 8 * w + tt; unsigned long long mk;
          if (i < 16) mk = (2ull << i) - 1ull;
          else { const int j = lane; const float iv = imp[j * IMP_PITCH + t8];
              const float sc = (j == 0 || j == i || j == i - 1) ? 5.0f : (j <= i ? iv : -1.0f);
              int rk = 0;
#pragma unroll 16
              for (int jp = 0; jp < 64; ++jp) { const float a = __uint_as_float(__builtin_amdgcn_readlane(__float_as_uint(sc), jp)); rk += (a > sc || (a == sc && jp < j)) ? 1 : 0; }
              mk = __ballot(rk < 16); }
          if (lane == 0) smk[t8] = mk;
          wu |= mk; }
      if (lane == 0) uni[w] = wu; }
    __syncthreads();
    unsigned long long um = 0ull;
#pragma unroll
    for (int k = 0; k < 8; ++k) um |= uni[k];
    um &= (i >= 63) ? ~0ull : ((2ull << i) - 1ull);
    const unsigned long long sm = smk[tq];
    const int kcol = C_KV + 2 * 128 + g * 64, vcol = C_KV + 3 * 128 + g * 64;
    f32x16 o[2]; o[0] = (f32x16){0.f}; o[1] = (f32x16){0.f}; float m_run = NEGF, l_run = 0.f;
    int kb = __builtin_ctzll(um); um &= um - 1ull;
    KVRegs R; kv_load(R, Hb, kb, kcol, vcol, tid);
    kv_store(R, L + OFF_BUF1, tid);
    __syncthreads();
    int cur = 1;
    for (;;) {
        const bool more = um != 0ull; int nkb = 0;
        if (more) { nkb = __builtin_ctzll(um); um &= um - 1ull; kv_load(R, Hb, nkb, kcol, vcol, tid); }
        LAS const unsigned char* buf = L + (cur ? OFF_BUF1 : OFF_BUF0);
        f32x16 p0, p1; qk_step(buf, qf, p0, p1, ql, hi);
        if (kb == i) mask_le(p0, p1, tq - 4 * hi);
        if (!((sm >> kb) & 1ull)) { p0 = (f32x16){NEGF, NEGF, NEGF, NEGF, NEGF, NEGF, NEGF, NEGF, NEGF, NEGF, NEGF, NEGF, NEGF, NEGF, NEGF, NEGF}; p1 = p0; }
        softmax_step(p0, p1, o, m_run, l_run);
        pv_step(buf, p0, p1, o, ql, hi);
        if (more) kv_store(R, L + (cur ? OFF_BUF0 : OFF_BUF1), tid);
        __syncthreads();
        if (!more) break;
        cur ^= 1; kb = nkb;
    }
    l_run += __shfl_xor(l_run, 32);
    const float inv = g1 / l_run;
    const bf16_t* wp = OWB + (size_t)row * 512 + h * 64 + 4 * hi;
    bf16_t* op = YC + (size_t)row * 2048 + 1536 + h * 64 + 4 * hi;
#pragma unroll
    for (int dt = 0; dt < 2; ++dt)
#pragma unroll
        for (int rr = 0; rr < 4; ++rr) { const u32x2 ww = *(const u32x2*)(wp + 32 * dt + 8 * rr);
            const float y0 = acc[dt][4 * rr] + o[dt][4 * rr] * inv + g2 * __uint_as_float(ww.x << 16), y1 = acc[dt][4 * rr + 1] + o[dt][4 * rr + 1] * inv + g2 * __uint_as_float(ww.x & 0xffff0000u);
            const float y2 = acc[dt][4 * rr + 2] + o[dt][4 * rr + 2] * inv + g2 * __uint_as_float(ww.y << 16), y3 = acc[dt][4 * rr + 3] + o[dt][4 * rr + 3] * inv + g2 * __uint_as_float(ww.y & 0xffff0000u);
            u32x2 wv; wv.x = pk_bf16(y0, y1); wv.y = pk_bf16(y2, y3); *(u32x2*)(op + 32 * dt + 8 * rr) = wv; }
}
}
namespace s5 {
constexpr size_t TT_L = (size_t)32 * 512 * 512, FT_L = (size_t)32 * 128 * 512, ET_L = (size_t)32 * 512 * 128;
struct Cplx { float r, i; };
__device__ __forceinline__ Cplx cmul(Cplx a, Cplx b) { return Cplx{a.r * b.r - a.i * b.i, a.r * b.i + a.i * b.r}; }
__device__ __forceinline__ Cplx apow(float dt, float are, float aim, float tau) { const float mg = expf(tau * dt * are); float sn, cs; sincosf(tau * dt * aim, &sn, &cs); return Cplx{mg * cs, mg * sn}; }
__device__ __forceinline__ Cplx apow_fast(float dt, float are, float aim, float tau) { const float mg = __expf(tau * dt * are), ph = tau * dt * aim; return Cplx{mg * __cosf(ph), mg * __sinf(ph)}; }
__device__ __forceinline__ Cplx fcoef(float dt, float are, float aim) {
    const Cplx ab = apow(dt, are, aim, 1.0f); const float den = are * are + aim * aim, nr = ab.r - 1.0f;
    return Cplx{(nr * are + ab.i * aim) / den, (ab.i * are - nr * aim) / den};
}
__device__ __forceinline__ void build_tt(int id, const SsmP& P, bf16_t* __restrict__ TT) {
    const int co = id & 15, tq = (id >> 4) % 63, g = id / (63 * 16), tau = tq - 31;
    float kv[16];
#pragma unroll
    for (int c = 0; c < 16; ++c) kv[c] = 0.f;
    if (tau >= 0) {
        const float dt = expf(P.log_dt[g]);
        for (int n = 0; n < 64; ++n) { const int gn = g * 64 + n; const float are = P.a_re[gn], aim = P.a_im[gn];
            const Cplx cc = Cplx{P.c_re[(g * 16 + co) * 64 + n], P.c_im[(g * 16 + co) * 64 + n]};
            const Cplx w = cmul(cmul(cc, apow_fast(dt, are, aim, (float)tau)), fcoef(dt, are, aim));
#pragma unroll
            for (int c = 0; c < 16; ++c) { const float br = P.b_re[gn * 16 + c], bi = P.b_im[gn * 16 + c]; kv[c] += w.r * br - w.i * bi; } }
        if (tau == 0) {
#pragma unroll
            for (int c = 0; c < 16; ++c) if (c == co) kv[c] += P.d[g * 16 + co];
        }
    }
    u32x4 w0, w1;
    w0.x = (unsigned)f2bf(kv[0]) | ((unsigned)f2bf(kv[1]) << 16); w0.y = (unsigned)f2bf(kv[2]) | ((unsigned)f2bf(kv[3]) << 16); w0.z = (unsigned)f2bf(kv[4]) | ((unsigned)f2bf(kv[5]) << 16); w0.w = (unsigned)f2bf(kv[6]) | ((unsigned)f2bf(kv[7]) << 16);
    w1.x = (unsigned)f2bf(kv[8]) | ((unsigned)f2bf(kv[9]) << 16); w1.y = (unsigned)f2bf(kv[10]) | ((unsigned)f2bf(kv[11]) << 16); w1.z = (unsigned)f2bf(kv[12]) | ((unsigned)f2bf(kv[13]) << 16); w1.w = (unsigned)f2bf(kv[14]) | ((unsigned)f2bf(kv[15]) << 16);
    for (int t = 0; t < 32; ++t) { const int s = t - tau; if (s < 0 || s > 31) continue;
        bf16_t* p = TT + ((size_t)g * 512 + t * 16 + co) * 512 + s * 16; *(u32x4*)p = w0; *(u32x4*)(p + 8) = w1; }
}
__device__ __forceinline__ void build_ft(int id, const SsmP& P, bf16_t* __restrict__ FT) {
    const int s = id & 31, n = (id >> 5) & 63, g = id >> 11, gn = g * 64 + n;
    const float dt = expf(P.log_dt[g]), are = P.a_re[gn], aim = P.a_im[gn];
    const Cplx w = cmul(apow_fast(dt, are, aim, (float)(31 - s)), fcoef(dt, are, aim));
    bf16_t* pr = FT + ((size_t)g * 128 + n) * 512 + s * 16; bf16_t* pi = pr + (size_t)64 * 512;
#pragma unroll
    for (int c = 0; c < 16; ++c) { const float br = P.b_re[gn * 16 + c], bi = P.b_im[gn * 16 + c]; pr[c] = f2bf(w.r * br - w.i * bi); pi[c] = f2bf(w.r * bi + w.i * br); }
}
__device__ __forceinline__ void build_et(int id, const SsmP& P, bf16_t* __restrict__ ET) {
    const int t = id & 31, n = (id >> 5) & 63, g = id >> 11, gn = g * 64 + n;
    const float dt = expf(P.log_dt[g]), are = P.a_re[gn], aim = P.a_im[gn];
    const Cplx ap = apow_fast(dt, are, aim, (float)(t + 1));
#pragma unroll
    for (int co = 0; co < 16; ++co) { const Cplx cc = Cplx{P.c_re[(g * 16 + co) * 64 + n], P.c_im[(g * 16 + co) * 64 + n]}; const Cplx p = cmul(cc, ap);
        bf16_t* q = ET + ((size_t)g * 512 + t * 16 + co) * 128 + n; q[0] = f2bf(p.r); q[64] = f2bf(-p.i); }
}

typedef float f32x4v __attribute__((ext_vector_type(4)));
#define MFMA16(a, b, c) __builtin_amdgcn_mfma_f32_16x16x32_bf16(a, b, c, 0, 0, 0)
__device__ __forceinline__ void ssm_a_unit(const bf16_t* __restrict__ H, const bf16_t* __restrict__ FT, float* __restrict__ SB, int g, int mt8) {
    const int tid = ltid(), lane = tid & 63, w = __builtin_amdgcn_readfirstlane(tid >> 6), fr = lane & 15, fq = lane >> 4;
    const int b = mt8 >> 2, c0 = (mt8 & 3) * 32;
    const bf16_t* ub = H + ((size_t)b * TP + (size_t)(c0 + fr) * 32 + (fq >> 1)) * 4096 + C_USSM + g * 16 + 8 * (fq & 1);
    const bf16_t* fb = FT + ((size_t)g * 128 + 16 * w + fr) * 512 + 8 * fq;
    f32x4v a0 = {0.f, 0.f, 0.f, 0.f}, a1 = a0;
#pragma unroll 4
    for (int ks = 0; ks < 16; ++ks) {
        const bf16x8 f = *(const bf16x8*)(fb + 32 * ks);
        const bf16x8 u0 = *(const bf16x8*)(ub + (size_t)(2 * ks) * 4096), u1 = *(const bf16x8*)(ub + (size_t)(16 * 32 + 2 * ks) * 4096);
        a0 = MFMA16(f, u0, a0); a1 = MFMA16(f, u1, a1);
    }
    float* sp = SB + (((size_t)b * 128 + c0 + fr) * 32 + g) * 128 + 16 * w + 4 * fq;
    *(f32x4v*)sp = a0; *(f32x4v*)(sp + (size_t)16 * 32 * 128) = a1;
}
__device__ __forceinline__ float gelu_t(float x) { const float u = 0.7978845608028654f * (x + 0.044715f * x * x * x); return 0.5f * x * (1.0f + tanhf(u)); }
constexpr int HIN_PITCH = 272;
__device__ __forceinline__ void ssm_b_unit(LAS unsigned char* L, const SsmP& P, const bf16_t* __restrict__ H, const bf16_t* __restrict__ TT, const bf16_t* __restrict__ ET, const float* __restrict__ SB,
                                           bf16_t* __restrict__ YA, float* __restrict__ o_re, float* __restrict__ o_im, int g, int mt8) {
    const int tid = ltid(), lane = tid & 63, w = __builtin_amdgcn_readfirstlane(tid >> 6), fr = lane & 15, fq = lane >> 4;
    const int b = mt8 >> 2, c0 = (mt8 & 3) * 32;
    __syncthreads();
    if (w == 0) {
        const int gn = g * 64 + lane; const float dt = expf(P.log_dt[g]);
        const Cplx a32 = apow(dt, P.a_re[gn], P.a_im[gn], 32.0f);
        Cplx h = Cplx{0.f, 0.f};
        const float* sp = SB + (((size_t)b * 128) * 32 + g) * 128 + lane;
        const int cend = c0 + 32;
        for (int c = 0; c < cend; ++c) {
            if (c >= c0) { LAS unsigned short* hp = (LAS unsigned short*)(L + (c - c0) * HIN_PITCH); hp[lane] = f2bf(h.r); hp[64 + lane] = f2bf(h.i); }
            const float sr = sp[(size_t)c * 32 * 128], si = sp[(size_t)c * 32 * 128 + 64];
            const Cplx nh = cmul(a32, h); h = Cplx{nh.r + sr, nh.i + si};
        }
        if (cend == 128) { o_re[b * 2048 + gn] = h.r; o_im[b * 2048 + gn] = h.i; }
    }
    __syncthreads();
    const bf16_t* ub = H + ((size_t)b * TP + (size_t)(c0 + fr) * 32 + (fq >> 1)) * 4096 + C_USSM + g * 16 + 8 * (fq & 1);
#pragma unroll
    for (int nt = 0; nt < 4; ++nt) {
        const int t = (nt == 0) ? w : (nt == 1) ? 15 - w : (nt == 2) ? 16 + w : 31 - w;
        const bf16_t* tb = TT + ((size_t)g * 512 + t * 16 + fr) * 512 + 8 * fq;
        const bf16_t* eb = ET + ((size_t)g * 512 + t * 16 + fr) * 128 + 8 * fq;
        f32x4v a0 = {0.f, 0.f, 0.f, 0.f}, a1 = a0;
        const int nks = t / 2 + 1;
#pragma unroll 2
        for (int ks = 0; ks < nks; ++ks) {
            const bf16x8 f = *(const bf16x8*)(tb + 32 * ks);
            const bf16x8 u0 = *(const bf16x8*)(ub + (size_t)(2 * ks) * 4096), u1 = *(const bf16x8*)(ub + (size_t)(16 * 32 + 2 * ks) * 4096);
            a0 = MFMA16(f, u0, a0); a1 = MFMA16(f, u1, a1);
        }
#pragma unroll
        for (int ks = 0; ks < 4; ++ks) {
            const bf16x8 f = *(const bf16x8*)(eb + 32 * ks);
            const bf16x8 h0 = *(LAS const bf16x8*)(L + fr * HIN_PITCH + (32 * ks + 8 * fq) * 2), h1 = *(LAS const bf16x8*)(L + (16 + fr) * HIN_PITCH + (32 * ks + 8 * fq) * 2);
            a0 = MFMA16(f, h0, a0); a1 = MFMA16(f, h1, a1);
        }
        bf16_t* yp = YA + ((size_t)b * TP + (size_t)(c0 + fr) * 32 + t) * 512 + g * 16 + 4 * fq;
        u32x2 v0, v1; v0.x = att::pk_bf16(gelu_t(a0[0]), gelu_t(a0[1])); v0.y = att::pk_bf16(gelu_t(a0[2]), gelu_t(a0[3])); v1.x = att::pk_bf16(gelu_t(a1[0]), gelu_t(a1[1])); v1.y = att::pk_bf16(gelu_t(a1[2]), gelu_t(a1[3]));
        *(u32x2*)yp = v0; *(u32x2*)(yp + (size_t)16 * 32 * 512) = v1;
    }
}
__device__ __forceinline__ void glu_unit(const bf16_t* __restrict__ YA, const bf16_t* __restrict__ GT, const float* __restrict__ bglu, bf16_t* __restrict__ YC, int r0) {
    const int tid = ltid(), lane = tid & 63, w = __builtin_amdgcn_readfirstlane(tid >> 6), fr = lane & 15, fq = lane >> 4;
    const bf16_t* ab = YA + (size_t)(r0 + fr) * 512 + 8 * fq;
    const bf16_t* gb = GT + (size_t)(64 * w + fr) * 512 + 8 * fq;
    f32x4v acc[2][4];
#pragma unroll
    for (int m = 0; m < 2; ++m)
#pragma unroll
        for (int n = 0; n < 4; ++n) acc[m][n] = (f32x4v){0.f, 0.f, 0.f, 0.f};
#pragma unroll 2
    for (int ks = 0; ks < 16; ++ks) {
        const bf16x8 x0 = *(const bf16x8*)(ab + 32 * ks), x1 = *(const bf16x8*)(ab + (size_t)16 * 512 + 32 * ks);
#pragma unroll
        for (int n = 0; n < 4; ++n) { const bf16x8 f = *(const bf16x8*)(gb + (size_t)(16 * n) * 512 + 32 * ks); acc[0][n] = MFMA16(f, x0, acc[0][n]); acc[1][n] = MFMA16(f, x1, acc[1][n]); }
    }
#pragma unroll
    for (int m = 0; m < 2; ++m)
#pragma unroll
        for (int n = 0; n < 4; ++n) { const int row = r0 + 16 * m + fr, j = 64 * w + 16 * n + 4 * fq;
            const u32x2 yv = *(const u32x2*)(YA + (size_t)row * 512 + j); const f32x4v bb = *(const f32x4v*)(bglu + j);
            const float y0 = __uint_as_float(yv.x << 16), y1 = __uint_as_float(yv.x & 0xffff0000u), y2 = __uint_as_float(yv.y << 16), y3 = __uint_as_float(yv.y & 0xffff0000u);
            const f32x4v z = acc[m][n] + bb;
            u32x2 o; o.x = att::pk_bf16(y0 / (1.f + __expf(-z[0])), y1 / (1.f + __expf(-z[1]))); o.y = att::pk_bf16(y2 / (1.f + __expf(-z[2])), y3 / (1.f + __expf(-z[3])));
            *(u32x2*)(YC + (size_t)row * 2048 + j) = o; }
}
constexpr int PL_PITCH = 1040;
__device__ __forceinline__ void convpool_unit(LAS unsigned char* L, const CpP& P, const bf16_t* __restrict__ H, const bf16_t* __restrict__ PWT, bf16_t* __restrict__ YC,
                                              float* __restrict__ o_conv, float* __restrict__ o_pool, int u) {
    const int tid = ltid(), lane = tid & 63, w = __builtin_amdgcn_readfirstlane(tid >> 6), fr = lane & 15, fq = lane >> 4;
    const int b = u >> 6, t0 = (u & 63) * 64, ch = tid;
    const bf16_t* Hb = H + (size_t)b * TP * 4096;
    __syncthreads();
    {
        const float w0 = P.conv_w[ch], w1 = P.conv_w[512 + ch], w2 = P.conv_w[1024 + ch], cb = P.conv_b[ch];
        float e2 = 0.f, e1 = 0.f;
        if (t0 > 0) { const bf16_t* r2 = Hb + (size_t)(t0 - 2) * 4096; const bf16_t* r1 = r2 + 4096; e2 = bf2f(r2[C_GC + ch]) * bf2f(r2[C_VC + ch]); e1 = bf2f(r1[C_GC + ch]) * bf2f(r1[C_VC + ch]); }
#pragma unroll 4
        for (int tt = 0; tt < 64; ++tt) { const bf16_t* r = Hb + (size_t)(t0 + tt) * 4096; const float cv = bf2f(r[C_GC + ch]) * bf2f(r[C_VC + ch]);
            YC[((size_t)b * TP + t0 + tt) * 2048 + 512 + ch] = f2bf(bf2f(r[C_GB + ch]) * (cb + w0 * e2 + w1 * e1 + w2 * cv));
            if (t0 + tt >= TP - 2) o_conv[(b * 2 + (t0 + tt - (TP - 2))) * 512 + ch] = cv;
            e2 = e1; e1 = cv; }
    }
    {
        const int wsel = ch >> 7; float hs[16];
#pragma unroll
        for (int k = 0; k < 16; ++k) hs[k] = 0.f;
        if (t0 > 0) {
#pragma unroll
            for (int k = 0; k < 15; ++k) hs[k] = bf2f(Hb[(size_t)(t0 - 1 - k) * 4096 + C_UP + ch]);
        }
#pragma unroll 2
        for (int tt = 0; tt < 64; ++tt) { const int t = t0 + tt; const float ut = bf2f(Hb[(size_t)t * 4096 + C_UP + ch]);
#pragma unroll
            for (int k = 15; k > 0; --k) hs[k] = hs[k - 1];
            hs[0] = ut;
            const float s2 = hs[0] + hs[1], s4 = s2 + hs[2] + hs[3], s8 = s4 + (hs[4] + hs[5]) + (hs[6] + hs[7]), s16 = s8 + ((hs[8] + hs[9]) + (hs[10] + hs[11])) + ((hs[12] + hs[13]) + (hs[14] + hs[15]));
            const float sum = wsel == 0 ? s2 : wsel == 1 ? s4 : wsel == 2 ? s8 : s16; const int wl = 2 << wsel, cnt = (t + 1 < wl) ? t + 1 : wl;
            *(LAS unsigned short*)(L + tt * PL_PITCH + ch * 2) = f2bf(sum / (float)cnt - ut);
            if (t >= TP - 15) o_pool[(b * 15 + (t - (TP - 15))) * 512 + ch] = ut; }
    }
    __syncthreads();
    {
        const int gi = w >> 1, nb = (w & 1) * 4;
        f32x4v acc[4][4];
#pragma unroll
        for (int m = 0; m < 4; ++m)
#pragma unroll
            for (int n = 0; n < 4; ++n) acc[m][n] = (f32x4v){0.f, 0.f, 0.f, 0.f};
#pragma unroll
        for (int ks = 0; ks < 4; ++ks) {
            bf16x8 xa[4];
#pragma unroll
            for (int m = 0; m < 4; ++m) xa[m] = *(LAS const bf16x8*)(L + (16 * m + fr) * PL_PITCH + (gi * 128 + 32 * ks + 8 * fq) * 2);
#pragma unroll
            for (int n = 0; n < 4; ++n) { const bf16x8 f = *(const bf16x8*)(PWT + ((size_t)gi * 128 + 16 * (nb + n) + fr) * 128 + 32 * ks + 8 * fq);
#pragma unroll
                for (int m = 0; m < 4; ++m) acc[m][n] = MFMA16(f, xa[m], acc[m][n]); }
        }
#pragma unroll
        for (int m = 0; m < 4; ++m)
#pragma unroll
            for (int n = 0; n < 4; ++n) { const int j = gi * 128 + 16 * (nb + n) + 4 * fq; const f32x4v sc = *(const f32x4v*)(P.pool_scale + j); const f32x4v y = acc[m][n] * sc;
                u32x2 o; o.x = att::pk_bf16(y[0], y[1]); o.y = att::pk_bf16(y[2], y[3]);
                *(u32x2*)(YC + ((size_t)b * TP + t0 + 16 * m + fr) * 2048 + 1024 + j) = o; }
    }
}
#undef MFMA16
}
namespace satt {
using att::f32x16;
constexpr int WBUF = att::KT_BYTES + att::VT_BYTES;
constexpr int OFF_X = 8 * WBUF;
constexpr int OFF_IMP2 = OFF_X;
constexpr int OFF_SM2 = OFF_IMP2 + 2048;
constexpr int OFF_ML = OFF_SM2 + 64;
constexpr int SATT_LDS = OFF_ML + 16 * 256;
constexpr int PSET = 8192;
static_assert(16 * PSET <= OFF_X && SATT_LDS <= RING_BYTES, "sample attention LDS map");

template <class KF, class VF>
__device__ __forceinline__ void stage_tile(LAS unsigned char* buf, int lane, int nvalid, KF krow, VF vrow) {
    const int sub = lane >> 4, dq = lane & 15;
#pragma unroll 4
    for (int it = 0; it < 16; ++it) {
        const int key = 4 * it + sub;
        f32x4 kv = {0.f, 0.f, 0.f, 0.f}, vv = kv;
        if (key < nvalid) { kv = *(const f32x4*)(krow(key) + 4 * dq); vv = *(const f32x4*)(vrow(key) + 4 * dq); }
        u32x2 kw; kw.x = att::pk_bf16(kv[0], kv[1]); kw.y = att::pk_bf16(kv[2], kv[3]);
        *(LAS u32x2*)(buf + key * att::KS_B + dq * 8) = kw;
        LAS unsigned short* vt = (LAS unsigned short*)(buf + att::KT_BYTES) + (4 * dq) * (att::VS_B / 2) + key;
        vt[0] = f2bf(vv[0]); vt[att::VS_B / 2] = f2bf(vv[1]); vt[2 * (att::VS_B / 2)] = f2bf(vv[2]); vt[3 * (att::VS_B / 2)] = f2bf(vv[3]);
    }
}
struct St { f32x16 o[2]; float m, l; };
__device__ __forceinline__ void st_init(St& s) { s.o[0] = (f32x16){0.f}; s.o[1] = (f32x16){0.f}; s.m = NEGF; s.l = 0.f; }
__device__ __forceinline__ void put_set(LAS unsigned char* L, int set, const St& s, int lane) {
    LAS float* po = (LAS float*)(L + set * PSET);
#pragma unroll
    for (int dt = 0; dt < 2; ++dt)
#pragma unroll
        for (int r = 0; r < 16; ++r) po[(dt * 16 + r) * 64 + lane] = s.o[dt][r];
    const float lt = s.l + __shfl_xor(s.l, 32);
    if (lane < 32) { LAS float* ml = (LAS float*)(L + OFF_ML) + set * 64 + lane * 2; ml[0] = s.m; ml[1] = lt; }
}

struct SP { const bf16_t* H; const float* KCS; const float* cache; const float* wcache; const float* okvs; const float* owins; const int* pt; bf16_t* YC; const unsigned long long* seldbg; };
__device__ __forceinline__ void sample_unit(LAS unsigned char* L, const SP& P, int bs, int g) {
    const int tid = ltid(), lane = tid & 63, w = __builtin_amdgcn_readfirstlane(tid >> 6), ql = lane & 31, hi = lane >> 5;
    const int qrow = ql & 15, ts = qrow >> 2, r = qrow & 3, h = 4 * g + r, row = MP + 4 * bs + ts;
    LAS unsigned char* buf = L + w * WBUF;
    LAS float* imp2 = (LAS float*)(L + OFF_IMP2); LAS unsigned long long* sm2 = (LAS unsigned long long*)(L + OFF_SM2); LAS float* ML = (LAS float*)(L + OFF_ML);
    bf16x8 qf[4]; att::load_q(qf, P.H, row, h, hi);
    __syncthreads();
    for (int e = tid; e < 512; e += 512) imp2[e] = 0.f;
    St sa; st_init(sa);
    f32x16 p0, p1;
    if (w < 2) {
        const float* kb = P.KCS + ((size_t)(bs * 128 + 64 * w) * 2) * 128 + g * 64;
        stage_tile(buf, lane, 64, [&](int key) { return kb + (size_t)key * 256; }, [&](int key) { return kb + (size_t)key * 256 + 128; });
        att::qk_step(buf, qf, p0, p1, ql, hi);
        att::softmax_step(p0, p1, sa.o, sa.m, sa.l);
        att::pv_step(buf, p0, p1, sa.o, ql, hi);
        const float lt = sa.l + __shfl_xor(sa.l, 32);
        if (lane < 32) { ML[w * 64 + lane * 2] = sa.m; ML[w * 64 + lane * 2 + 1] = lt; }
    } else {
        for (int c = w - 2; c < 9; c += 6) {
            const float* wb = P.wcache + ((size_t)bs * 512) * 256 + g * 64; const float* nb = P.owins + ((size_t)bs * 512 + 508) * 256 + g * 64;
            const int nv = (c < 8) ? 64 : 4;
            stage_tile(buf, lane, nv, [&](int key) { const int idx = 64 * c + key; return idx < 512 ? wb + (size_t)idx * 256 : nb + (size_t)(idx - 512) * 256; },
                                      [&](int key) { const int idx = 64 * c + key; return (idx < 512 ? wb + (size_t)idx * 256 : nb + (size_t)(idx - 512) * 256) + 128; });
            att::qk_step(buf, qf, p0, p1, ql, hi);
            if (c == 0) att::mask_gt(p0, p1, ts - 4 * hi);
            if (c == 8) att::mask_le(p0, p1, ts - 4 * hi);
            att::softmax_step(p0, p1, sa.o, sa.m, sa.l);
            att::pv_step(buf, p0, p1, sa.o, ql, hi);
        }
    }
    __syncthreads();
    if (w < 2) {
        const float m0 = ML[ql * 2], l0 = ML[ql * 2 + 1], m1 = ML[64 + ql * 2], l1 = ML[64 + ql * 2 + 1];
        const float M = fmaxf(m0, m1), Lt = l0 * __builtin_amdgcn_exp2f(m0 - M) + l1 * __builtin_amdgcn_exp2f(m1 - M);
        const float sc = __builtin_amdgcn_exp2f(sa.m - M) / Lt;
        if (ql < 16) {
#pragma unroll
            for (int rr = 0; rr < 16; ++rr) { const int c = (rr & 3) + 8 * (rr >> 2) + 4 * hi;
                __hip_atomic_fetch_add(imp2 + (64 * w + c) * 4 + ts, p0[rr] * sc, __ATOMIC_RELAXED, __HIP_MEMORY_SCOPE_WORKGROUP);
                __hip_atomic_fetch_add(imp2 + (64 * w + c + 32) * 4 + ts, p1[rr] * sc, __ATOMIC_RELAXED, __HIP_MEMORY_SCOPE_WORKGROUP); }
        }
    }
    __syncthreads();
    if (w < 4) {
        const int pos = PAST + w, cur = pos >> 6, j0 = lane, j1 = lane + 64;
        const float i0 = imp2[j0 * 4 + w], i1 = imp2[j1 * 4 + w];
        const float sc0 = (j0 == 0 || j0 == cur || j0 == cur - 1) ? 5.0f : i0;
        const float sc1 = (j1 == 0 || j1 == cur || j1 == cur - 1) ? 5.0f : i1;
        int rk0 = 1, rk1 = (5.0f > sc1) ? 1 : 0;
        rk0 = (5.0f > sc0) ? 1 : 0;
#pragma unroll 8
        for (int jp = 0; jp < 64; ++jp) {
            const float a = __uint_as_float(__builtin_amdgcn_readlane(__float_as_uint(sc0), jp)), c = __uint_as_float(__builtin_amdgcn_readlane(__float_as_uint(sc1), jp));
            rk0 += ((a > sc0 || (a == sc0 && jp < j0)) ? 1 : 0) + ((c > sc0) ? 1 : 0);
            rk1 += ((a >= sc1) ? 1 : 0) + ((c > sc1 || (c == sc1 && jp < lane)) ? 1 : 0);
        }
        const unsigned long long b0 = __ballot(rk0 < 16), b1 = __ballot(rk1 < 16);
        if (lane == 0) { sm2[w * 2] = b0; sm2[w * 2 + 1] = b1;
#if defined(DIAG3) && DIAG3
            if (P.seldbg) { const unsigned long long* sp = P.seldbg + (size_t)((MP + 4 * bs + w) * 2 + g) * 3; sm2[w * 2] = sp[0]; sm2[w * 2 + 1] = sp[1]; }
#endif
        }
    }
    __syncthreads();
    unsigned long long u0 = sm2[0] | sm2[2] | sm2[4] | sm2[6], u1 = sm2[1] | sm2[3] | sm2[5] | sm2[7];
    const unsigned long long my0 = sm2[ts * 2], my1 = sm2[ts * 2 + 1];
    St sc_; st_init(sc_);
    {
        int n = 0;
        for (int half = 0; half < 2; ++half) { unsigned long long um = half ? u1 : u0;
            while (um) { const int bit = __builtin_ctzll(um); um &= um - 1ull;
                if ((n & 7) == w) { const int kb = 64 * half + bit; const int page = P.pt[bs * NPG + (kb >> 1)];
                    const float* cb = P.cache + ((size_t)page * 128 + (kb & 1) * 64) * 512 + 2 * 128 + g * 64;
                    stage_tile(buf, lane, 64, [&](int key) { return cb + (size_t)key * 512; }, [&](int key) { return cb + (size_t)key * 512 + 128; });
                    att::qk_step(buf, qf, p0, p1, ql, hi);
                    const bool sel = ((half ? my1 : my0) >> bit) & 1ull;
                    if (!sel) { p0 = (f32x16){NEGF, NEGF, NEGF, NEGF, NEGF, NEGF, NEGF, NEGF, NEGF, NEGF, NEGF, NEGF, NEGF, NEGF, NEGF, NEGF}; p1 = p0; }
                    att::softmax_step(p0, p1, sc_.o, sc_.m, sc_.l);
                    att::pv_step(buf, p0, p1, sc_.o, ql, hi); }
                ++n; } }
        if ((n & 7) == w) {
            const float* nb = P.okvs + ((size_t)bs * 4) * 512 + 2 * 128 + g * 64;
            stage_tile(buf, lane, 4, [&](int key) { return nb + (size_t)key * 512; }, [&](int key) { return nb + (size_t)key * 512 + 128; });
            att::qk_step(buf, qf, p0, p1, ql, hi);
            att::mask_le(p0, p1, ts - 4 * hi);
            att::softmax_step(p0, p1, sc_.o, sc_.m, sc_.l);
            att::pv_step(buf, p0, p1, sc_.o, ql, hi);
        }
    }
    __syncthreads();
    put_set(L, w, sa, lane);
    put_set(L, 8 + w, sc_, lane);
    __syncthreads();
    {
        const int q = tid >> 5; const int tsq = q >> 2, rq = q & 3, hq = 4 * g + rq, rowq = MP + 4 * bs + tsq;
        const bf16_t* gp = P.H + (size_t)rowq * 4096 + C_GATE + hq * 3;
        const float gt[3] = {1.f / (1.f + __expf(-bf2f(gp[0]))), 1.f / (1.f + __expf(-bf2f(gp[1]))), 1.f / (1.f + __expf(-bf2f(gp[2])))};
        float y[2] = {0.f, 0.f};
#pragma unroll
        for (int br = 0; br < 3; ++br) { const int s0 = br == 0 ? 0 : br == 1 ? 8 : 2, s1 = br == 0 ? 2 : br == 1 ? 16 : 8; const float gate = br == 0 ? gt[0] : br == 1 ? gt[1] : gt[2];
            float M = NEGF;
            for (int s = s0; s < s1; ++s) M = fmaxf(M, ML[s * 64 + q * 2]);
            float Lt = 0.f, a0 = 0.f, a1 = 0.f;
            for (int s = s0; s < s1; ++s) { const float f = __builtin_amdgcn_exp2f(ML[s * 64 + q * 2] - M); Lt += ML[s * 64 + q * 2 + 1] * f;
#pragma unroll
                for (int e = 0; e < 2; ++e) { const int d = 2 * (tid & 31) + e, dt = d >> 5, dd = d & 31, hh = (dd >> 2) & 1, rr = (dd & 3) + 4 * (dd >> 3);
                    const float v = ((LAS const float*)(L + s * PSET))[(dt * 16 + rr) * 64 + q + 32 * hh] * f; if (e == 0) a0 += v; else a1 += v; } }
            const float inv = Lt > 0.f ? gate / Lt : 0.f; y[0] += a0 * inv; y[1] += a1 * inv; }
        *(unsigned*)(P.YC + (size_t)rowq * 2048 + 1536 + hq * 64 + 2 * (tid & 31)) = att::pk_bf16(y[0], y[1]);
    }
}
}
namespace sk {
typedef float f32x4v __attribute__((ext_vector_type(4)));
template <int NT, int MODE>
__device__ __forceinline__ void unit(const bf16_t* __restrict__ A, int lda, const bf16_t* __restrict__ Wt, int K, int n0, int k0, int ksteps,
                                     bf16_t* __restrict__ OB, float* __restrict__ OF, const float* __restrict__ res, float* __restrict__ okv, float* __restrict__ owin) {
    const int tid = ltid(), lane = tid & 63, w = __builtin_amdgcn_readfirstlane(tid >> 6), fr = lane & 15, fq = lane >> 4;
    const bf16_t* ap = A + (size_t)(16 * w + fr) * lda + k0 + 8 * fq;
    const bf16_t* wp = Wt + (size_t)(n0 + fr) * K + k0 + 8 * fq;
    f32x4v acc[NT];
#pragma unroll
    for (int n = 0; n < NT; ++n) acc[n] = (f32x4v){0.f, 0.f, 0.f, 0.f};
#pragma unroll 8
    for (int ks = 0; ks < ksteps; ++ks) {
        const bf16x8 a = *(const bf16x8*)(ap + 32 * ks);
#pragma unroll
        for (int n = 0; n < NT; ++n) { const bf16x8 wv = *(const bf16x8*)(wp + (size_t)(16 * n) * K + 32 * ks); acc[n] = __builtin_amdgcn_mfma_f32_16x16x32_bf16(wv, a, acc[n], 0, 0, 0); }
    }
    const int m = 16 * w + fr;
#pragma unroll
    for (int nt = 0; nt < NT; ++nt) { const int n = n0 + 16 * nt + 4 * fq; const f32x4v v = acc[nt];
        if (MODE == 0) {
            if (n < NIN) {
                u32x2 o; o.x = att::pk_bf16(v[0], v[1]); o.y = att::pk_bf16(v[2], v[3]);
                *(u32x2*)(OB + (size_t)(MP + m) * 4096 + n) = o;
                if (n >= 3072 && n < 3584) *(f32x4v*)(okv + (size_t)m * 512 + (n - 3072)) = v;
                if (n >= 3584 && n < 3840) { const int bs = m >> 2, ts = m & 3; *(f32x4v*)(owin + ((size_t)(bs * 512 + 508 + ts) * 256 + (n - 3584))) = v; }
            }
        } else if (MODE == 1) { const size_t off = (size_t)m * 2048 + n; const f32x4v r = *(const f32x4v*)(res + off); *(f32x4v*)(OF + off) = r * ALPHA + v;
        } else if (MODE == 2) { f32x4v q = v;
#pragma unroll
            for (int e = 0; e < 4; ++e) { const float t = fmaxf(q[e], 0.f); q[e] = t * t; }
            u32x2 o; o.x = att::pk_bf16(q[0], q[1]); o.y = att::pk_bf16(q[2], q[3]); *(u32x2*)(OB + (size_t)(MP + m) * 8192 + n) = o;
        } else { *(f32x4v*)(OF + (size_t)m * 2048 + n) = v; }
    }
}
}
__device__ __forceinline__ void transpose_item(const float* __restrict__ W, int K, int N, int Npad, bf16_t* __restrict__ WT, LAS float* scr, int item, int lane) {
    const int nblk = Npad / 64, kb = item / nblk, nb = item % nblk, k0 = 64 * kb, n0 = 64 * nb;
    const int n4 = lane & 15, ksub = lane >> 4, n = n0 + 4 * n4;
    f32x4 v[16];
#pragma unroll
    for (int i = 0; i < 16; ++i) v[i] = (n < N) ? *(const f32x4*)(W + (size_t)(k0 + 4 * i + ksub) * N + n) : (f32x4){0.f, 0.f, 0.f, 0.f};
#pragma unroll
    for (int i = 0; i < 16; ++i) { LAS float* s = scr + (4 * i + ksub) * 65 + 4 * n4; s[0] = v[i][0]; s[1] = v[i][1]; s[2] = v[i][2]; s[3] = v[i][3]; }
    LDS_WAIT(); asm volatile("" ::: "memory");
    const int c = lane & 7;
#pragma unroll
    for (int j = 0; j < 8; ++j) { const int nn = (lane >> 3) + 8 * j; const LAS float* s = scr + (8 * c) * 65 + nn;
        u32x4 o; o.x = (unsigned)f2bf(s[0 * 65]) | ((unsigned)f2bf(s[1 * 65]) << 16); o.y = (unsigned)f2bf(s[2 * 65]) | ((unsigned)f2bf(s[3 * 65]) << 16);
        o.z = (unsigned)f2bf(s[4 * 65]) | ((unsigned)f2bf(s[5 * 65]) << 16); o.w = (unsigned)f2bf(s[6 * 65]) | ((unsigned)f2bf(s[7 * 65]) << 16);
        *(u32x4*)(WT + (size_t)(n0 + nn) * K + k0 + 8 * c) = o; }
    LDS_WAIT(); asm volatile("" ::: "memory");
}
__device__ __forceinline__ void compress_sample_item(const float* __restrict__ cache, const int* __restrict__ ptab, const float* __restrict__ wck, const float* __restrict__ wcv, float* __restrict__ KCSl, int item, int lane) {
    const int j = item & 127, bs = item >> 7, page = ptab[bs * NPG + (j >> 1)];
    const float* base = cache + ((size_t)page * 128 + (j & 1) * 64) * 512 + lane * 4;
    const float* wb = ((lane >> 5) ? wcv : wck) + ((lane * 4) & 63);
    f32x4 acc = {0.f, 0.f, 0.f, 0.f};
#pragma unroll 16
    for (int k = 0; k < 64; ++k) { const f32x4 x = __builtin_nontemporal_load((const f32x4*)(base + (size_t)k * 512)); const f32x4 wv = *(const f32x4*)(wb + k * 64); acc += x * wv; }
    *(f32x4*)(KCSl + (size_t)item * 256 + lane * 4) = acc;
}

__device__ __forceinline__ int q_next(gu32* ctr, volatile LAS unsigned* slot) {
    __syncthreads(); if (threadIdx.x == 0) *slot = __hip_atomic_fetch_add(ctr, 1u, RLX_AGENT); __syncthreads(); return (int)*slot;
}
constexpr int CW_Q = 8192;
#ifndef REP_PRO
#define REP_PRO 1
#endif
#ifndef REP_GEMM
#define REP_GEMM 1
#endif
#ifndef REP_P2
#define REP_P2 1
#endif
#ifndef REP_P3
#define REP_P3 1
#endif
#ifndef REP_P4
#define REP_P4 1
#endif
#ifndef REP_LN
#define REP_LN 1
#endif
struct Args { const float* in[33]; float* out; unsigned char* ws; int ph_lo, ph_hi; };
constexpr int NPH_LAYER = 9, NPH = 1 + 2 * NPH_LAYER;
#ifndef MK_PER_PHASE
#define MK_PER_PHASE 0
#endif

#define ws (a.ws)
#define in (a.in)
#define out (a.out)
#define ctl ((gu32*)(ws + WS_CTL))
#define XB ((bf16_t*)(ws + WS_XB))
#define XF ((float*)(ws + WS_XF))
#define H ((bf16_t*)(ws + WS_H))
#define YC ((bf16_t*)(ws + WS_YC))
#define PRE ((float*)(ws + WS_PRE))
#define X1F ((float*)(ws + WS_X1F))
#define X1B ((bf16_t*)(ws + WS_X1B))
#define HF ((bf16_t*)(ws + WS_HF))
#define KCS ((float*)(ws + WS_KCS))
#define KCP ((float*)(ws + WS_KCP))
#define SEL ((unsigned long long*)(ws + WS_SEL))
#define OC ((float*)(ws + WS_OC))
#define OS ((float*)(ws + WS_OS))
#define OW ((float*)(ws + WS_OW))
#define YA ((float*)(ws + WS_YA))
#define PL ((float*)(ws + WS_PL))
#define HS ((float*)(ws + WS_HS))
#define pt ((const int*)in[8])
#define PART ((float*)(ws + WS_PART))
#define TTB ((bf16_t*)(ws + WS_TT))
#define FTB ((bf16_t*)(ws + WS_FT))
#define ETB ((bf16_t*)(ws + WS_ET))
#define GTB ((bf16_t*)(ws + WS_GT))
#define PWTB ((bf16_t*)(ws + WS_PWT))
#define SBUF ((float*)(ws + WS_SB))
#define YAB ((bf16_t*)(ws + WS_YAB))
#define OWB ((bf16_t*)(ws + WS_OWB))
#define MISCQ ((volatile LAS unsigned*)(L + MISC_OFF) + 16)
#define IN(k) (lo <= (k) && (k) < hi)
#define SEAM(k) do { if (IN(k) && IN((k) + 1)) xcd_barrier(bar); } while (0)
#define VB_LOOP(NB, CALL) do { const int _nb = (NB); const int _t = ltid(); for (int _k = blockIdx.x; 2 * _k < _nb; _k += G) { const int vb = 2 * _k + (_t >> 8), vt = _t & 255; if (vb < _nb) { CALL; } } } while (0)


template <int l>
__device__ __forceinline__ void run_layer(const Args& a, LAS unsigned char* L, const XcdBarrier& bar, const int lo, const int hi, const int tid, const int G) {
        const int p0 = 1 + l * NPH_LAYER;
#define WIN ((const bf16_t*)(ws + WS_WIN) + (size_t)l * NINP * DM)
#define WOUT ((const bf16_t*)(ws + WS_WOUT) + (size_t)l * DM * DM)
#define WUP ((const bf16_t*)(ws + WS_WUP) + (size_t)l * DFF * DM)
#define WDN ((const bf16_t*)(ws + WS_WDN) + (size_t)l * DM * DFF)
#define sp (SsmP{in[10] + l * 2048, in[11] + l * 2048, in[12] + l * 32768, in[13] + l * 32768, in[14] + l * 32768, in[15] + l * 32768, in[16] + l * 512, in[17] + l * 32, in[18] + (size_t)l * 512 * 512, in[19] + l * 512})
#define cp (CpP{in[20] + l * 3 * 512, in[21] + l * 512, in[22] + (size_t)l * 4 * 128 * 128, in[23] + l * 512, in[6] + (size_t)l * 32 * 2 * 512, in[7] + (size_t)l * 32 * 15 * 512})
#define ap (AttP{H, in[2] + (size_t)l * NPOOLPG * 128 * 512, in[3] + (size_t)l * 32 * 512 * 256, pt})
        if (IN(p0 + 0)) for (int rep = 0; rep < REP_GEMM; ++rep) {
            pg8::Gemm g{XB, WIN, MP, NINP, DM}; pg8::StaticOrder S; S.init(MP, NINP, G, (int)blockIdx.x);
            pg8::EpiIn E{H, out + O_KVP + (size_t)l * MP * 512, out + O_WINP + (size_t)l * 2 * 512 * 256};
            pg8::gemm_phase<pg8::EpiIn, pg8::StaticOrder, true, true>(L + RING_OFF, g, S, E);
            for (int u = blockIdx.x; u < 242; u += G) sk::unit<1, 0>(XB + (size_t)MP * DM, DM, WIN, DM, 16 * u, 0, DM / 32, H, nullptr, nullptr, out + O_KVS + (size_t)l * MS * 512, out + O_WINS + (size_t)l * 32 * 512 * 256);
        }
        SEAM(p0 + 0);
        if (IN(p0 + 1)) for (int rep = 0; rep < REP_P2; ++rep) {
            for (int u = blockIdx.x; u < 256; u += G) s5::ssm_a_unit(H, FTB + (size_t)l * s5::FT_L, SBUF, u & 31, u >> 5);
            for (int u = blockIdx.x; u < 128; u += G) s5::convpool_unit(L, cp, H, PWTB + (size_t)l * 4 * 128 * 128, YC, out + O_CONVP + l * 2 * 2 * 512, out + O_POOLP + l * 2 * 15 * 512, u);
            VB_LOOP((32 * 2048) / 256, k_ssm_scan(vb, vt, 2, sp, H, in[4] + (size_t)l * 32 * 2048, in[5] + (size_t)l * 32 * 2048, HS,
                                                   out + O_SREP + l * 2 * 2048, out + O_SIMP + l * 2 * 2048, out + O_SRES + l * 32 * 2048, out + O_SIMS + l * 32 * 2048));
            VB_LOOP((MS * 512) / 256, k_convpool1(vb, vt, cp, H, YC, PL, out + O_CONVP + l * 2 * 2 * 512, out + O_CONVS + l * 32 * 2 * 512, out + O_POOLP + l * 2 * 15 * 512, out + O_POOLS + l * 32 * 15 * 512, MP));
            VB_LOOP((2 * 64 * 256) / 256, k_compress_prompt(vb, vt, H, in[24] + l * 4096, in[25] + l * 4096, KCP));
            VB_LOOP((32 * 508 * 64 + 255) / 256, k_wincopy(vb, vt, in[3] + (size_t)l * 32 * 512 * 256, out + O_WINS + (size_t)l * 32 * 512 * 256));
            for (int u = blockIdx.x; u < 256; u += G) att::window_unit(L, H, OWB, u & 1, (u >> 1) & 1, u >> 2);
        }
        SEAM(p0 + 1);
        if (IN(p0 + 2)) for (int rep = 0; rep < REP_P3; ++rep) {
            const satt::SP sps{H, KCS + (size_t)l * 32 * 128 * 256, in[2] + (size_t)l * NPOOLPG * 128 * 512, in[3] + (size_t)l * 32 * 512 * 256,
                               out + O_KVS + (size_t)l * MS * 512, out + O_WINS + (size_t)l * 32 * 512 * 256, pt, YC, nullptr};
            for (;;) { int q = q_next(ctl + CW_Q + 64 * (l * 8 + rep), MISCQ); if (q >= 576) break;
                if (q < 256) att::nsa_unit(L, H, KCP, OWB, YC, q & 1, (q >> 1) & 1, 63 - (q >> 2));
                else if (q < 320) satt::sample_unit(L, sps, (q - 256) >> 1, (q - 256) & 1);
                else if ((q -= 64), true) s5::ssm_b_unit(L, sp, H, TTB + (size_t)l * s5::TT_L, ETB + (size_t)l * s5::ET_L, SBUF, YAB, out + O_SREP + l * 2 * 2048, out + O_SIMP + l * 2 * 2048, (q - 256) & 31, (q - 256) >> 5); }
            VB_LOOP((MS * 512) / 256, k_ssm_y(vb, vt, MP, sp, H, HS, YAB));
            VB_LOOP((MS * 512) / 256, k_pool2(vb, vt, MP, cp, PL, YC));
        }
        SEAM(p0 + 2);
        if (IN(p0 + 3)) for (int rep = 0; rep < REP_P4; ++rep) {
            for (int u = blockIdx.x; u < MT / 32; u += G) s5::glu_unit(YAB, GTB + (size_t)l * 512 * 512, in[19] + l * 512, YC, 32 * u);
        }
        SEAM(p0 + 3);
        if (IN(p0 + 4)) for (int rep = 0; rep < REP_GEMM; ++rep) {
            pg8::Gemm g{YC, WOUT, MP, DM, DM}; pg8::StaticOrder S; S.init(MP, DM, G, (int)blockIdx.x);
            pg8::EpiRes E{l == 0 ? in[0] : XF, PRE, ALPHA};
            pg8::gemm_phase<pg8::EpiRes, pg8::StaticOrder, true, true>(L + RING_OFF, g, S, E);
            for (int u = blockIdx.x; u < 128; u += G) sk::unit<1, 1>(YC + (size_t)MP * DM, DM, WOUT, DM, 16 * u, 0, DM / 32, nullptr, PRE + (size_t)MP * DM, l == 0 ? in[1] : XF + (size_t)MP * DM, nullptr, nullptr);
        }
        SEAM(p0 + 4);
        if (IN(p0 + 5)) for (int rep = 0; rep < REP_LN; ++rep) { VB_LOOP(MT / 4, k_ln(vb, vt, PRE, in[27] + l * DM, in[28] + l * DM, X1F, X1F + (size_t)MP * DM, X1B)); }
        SEAM(p0 + 5);
        if (IN(p0 + 6)) for (int rep = 0; rep < REP_GEMM; ++rep) {
            pg8::Gemm g{X1B, WUP, MP, DFF, DM}; pg8::StaticOrder S; S.init(MP, DFF, G, (int)blockIdx.x);
            pg8::EpiRelu2 E{HF};
            pg8::gemm_phase<pg8::EpiRelu2, pg8::StaticOrder, true, true>(L + RING_OFF, g, S, E);
            for (int u = blockIdx.x; u < 256; u += G) sk::unit<2, 2>(X1B + (size_t)MP * DM, DM, WUP, DM, 32 * u, 0, DM / 32, HF, nullptr, nullptr, nullptr, nullptr);
        }
        SEAM(p0 + 6);
        if (IN(p0 + 7)) for (int rep = 0; rep < REP_GEMM; ++rep) {
            pg8::Gemm g{HF, WDN, MP, DM, DFF}; pg8::StaticOrder S; S.init(MP, DM, G, (int)blockIdx.x);
            pg8::EpiRes E{X1F, PRE, ALPHA};
            pg8::gemm_phase<pg8::EpiRes, pg8::StaticOrder, true, true>(L + RING_OFF, g, S, E);
            for (int u = blockIdx.x; u < 256; u += G) sk::unit<4, 3>(HF + (size_t)MP * DFF, DFF, WDN, DFF, 64 * (u & 31), 1024 * (u >> 5), 32, nullptr, PART + (size_t)(u >> 5) * MS * DM, nullptr, nullptr, nullptr);
        }
        SEAM(p0 + 7);
        if (IN(p0 + 8)) for (int rep = 0; rep < REP_LN; ++rep) {
            if (l == 0) { VB_LOOP(MT / 4, k_ln(vb, vt, PRE, in[31] + l * DM, in[32] + l * DM, XF, XF + (size_t)MP * DM, XB, PART, X1F + (size_t)MP * DM)); }
            else { VB_LOOP(MT / 4, k_ln(vb, vt, PRE, in[31] + l * DM, in[32] + l * DM, out + O_YP, out + O_YS, nullptr, PART, X1F + (size_t)MP * DM)); }
        }
        SEAM(p0 + 8);
    }

__global__ void __launch_bounds__(NWAVES * 64, 2) mk(Args a) {
    extern __shared__ __attribute__((aligned(16))) unsigned char lds[];
    LAS unsigned char* L = (LAS unsigned char*)lds;
    volatile LAS unsigned* MISC = (volatile LAS unsigned*)(L + MISC_OFF);
    const int tid = threadIdx.x, lane = tid & 63, wave = __builtin_amdgcn_readfirstlane(tid >> 6);
    const int G = gridDim.x;
    for (int u = tid; u < (LDS_BYTES - LDSCTL_OFF) / 4; u += NWAVES * 64) ((LAS unsigned*)(L + LDSCTL_OFF))[u] = 0u;
    __syncthreads();
    XcdBarrier bar; bar.bar = (unsigned*)(ctl + CW_BAR); bar.x = 0; bar.st = nullptr;
    if (!MK_PER_PHASE) bar = xcd_barrier_post((unsigned*)(ctl + CW_BAR), MISC + 8);
    const int lo = a.ph_lo, hi = a.ph_hi;
    if (IN(0)) for (int rep = 0; rep < REP_PRO; ++rep) {
        LAS float* scr = (LAS float*)(L + RING_OFF + wave * 16640);
        const int gw = blockIdx.x * NWAVES + wave, NGW = G * NWAVES;
        constexpr int I_IN = (DM / 64) * (NINP / 64), I_OUT = (DM / 64) * (DM / 64), I_UP = (DM / 64) * (DFF / 64), I_DN = (DFF / 64) * (DM / 64), I_L = I_IN + I_OUT + I_UP + I_DN;
        for (int it = gw; it < 2 * I_L; it += NGW) {
            const int l = it / I_L; int r = it % I_L;
            if (r < I_IN) { transpose_item(in[9] + (size_t)l * DM * NIN, DM, NIN, NINP, (bf16_t*)(ws + WS_WIN) + (size_t)l * NINP * DM, scr, r, lane); continue; } r -= I_IN;
            if (r < I_OUT) { transpose_item(in[26] + (size_t)l * DM * DM, DM, DM, DM, (bf16_t*)(ws + WS_WOUT) + (size_t)l * DM * DM, scr, r, lane); continue; } r -= I_OUT;
            if (r < I_UP) { transpose_item(in[29] + (size_t)l * DM * DFF, DM, DFF, DFF, (bf16_t*)(ws + WS_WUP) + (size_t)l * DFF * DM, scr, r, lane); continue; } r -= I_UP;
            transpose_item(in[30] + (size_t)l * DFF * DM, DFF, DM, DM, (bf16_t*)(ws + WS_WDN) + (size_t)l * DM * DFF, scr, r, lane);
        }
        for (int it = gw; it < 2 * (64 + 16); it += NGW) {
            const int l = it / 80, r = it % 80;
            if (r < 64) transpose_item(in[18] + (size_t)l * 512 * 512, 512, 512, 512, GTB + (size_t)l * 512 * 512, scr, r, lane);
            else { const int gi = (r - 64) >> 2; transpose_item(in[22] + ((size_t)l * 4 + gi) * 128 * 128, 128, 128, 128, PWTB + ((size_t)l * 4 + gi) * 128 * 128, scr, (r - 64) & 3, lane); }
        }
        {
            constexpr int T_TT = 32 * 63 * 16 / 64, T_FE = 32 * 64 * 32 / 64, T_L = T_TT + T_FE;
            for (int t = gw; t < 2 * T_L; t += NGW) { const int l = t / T_L, r = t % T_L;
                const SsmP spl{in[10] + l * 2048, in[11] + l * 2048, in[12] + l * 32768, in[13] + l * 32768, in[14] + l * 32768, in[15] + l * 32768, in[16] + l * 512, in[17] + l * 32, nullptr, nullptr};
                if (r < T_TT) s5::build_tt(r * 64 + lane, spl, TTB + (size_t)l * s5::TT_L);
                else { s5::build_ft((r - T_TT) * 64 + lane, spl, FTB + (size_t)l * s5::FT_L); s5::build_et((r - T_TT) * 64 + lane, spl, ETB + (size_t)l * s5::ET_L); } }
        }
        VB_LOOP((MT * DM / 4 + 255) / 256, k_x2bf(vb, vt, in[0], in[1], XB));
        for (int it = gw; it < 2 * 32 * 128; it += NGW) { const int l = it >> 12;
            compress_sample_item(in[2] + (size_t)l * NPOOLPG * 128 * 512, pt, in[24] + l * 4096, in[25] + l * 4096, KCS + (size_t)l * 32 * 128 * 256, it & 4095, lane); }
    }
    SEAM(0);
    run_layer<0>(a, L, bar, lo, hi, tid, G);
    run_layer<1>(a, L, bar, lo, hi, tid, G);
}

#undef IN
#undef SEAM
#undef VB_LOOP
#undef ws
#undef in
#undef out
#undef ctl
#undef XB
#undef XF
#undef H
#undef YC
#undef PRE
#undef X1F
#undef X1B
#undef HF
#undef KCS
#undef KCP
#undef SEL
#undef OC
#undef OS
#undef OW
#undef YA
#undef PL
#undef HS
#undef pt
#undef PART
#undef TTB
#undef FTB
#undef ETB
#undef GTB
#undef PWTB
#undef SBUF
#undef YAB
#undef OWB
#undef MISCQ
#undef WIN
#undef WOUT
#undef WUP
#undef WDN
#undef sp
#undef cp
#undef ap

extern "C" void kernel_launch(void* const* d_in, const int* in_sizes, int n_in, void* d_out, int out_size, void* d_ws, size_t ws_size, hipStream_t stream) {
    static int grid = 0;
    if (grid == 0) {
        if (n_in != 33 || (size_t)out_size != O_END || ws_size < WS_END) { fprintf(stderr, "kernel_launch: unexpected sizes n_in %d out %d ws %zu\n", n_in, out_size, ws_size); grid = -1; return; }
        int dev = 0, cus = 0;
        (void)hipGetDevice(&dev); (void)hipDeviceGetAttribute(&cus, hipDeviceAttributeMultiprocessorCount, dev);
        (void)hipFuncSetAttribute((const void*)mk, hipFuncAttributeMaxDynamicSharedMemorySize, LDS_BYTES);
        (void)hipGetLastError();
        grid = cus > 0 ? cus : 256;
    }
    if (grid < 0) return;
    (void)hipMemsetAsync((char*)d_ws + WS_CTL, 0, CTL_ZERO_BYTES, stream);
    Args a{}; for (int i = 0; i < 33; ++i) a.in[i] = (const float*)d_in[i]; a.out = (float*)d_out; a.ws = (unsigned char*)d_ws;
#if MK_PER_PHASE
    for (int p = 0; p < NPH; ++p) { a.ph_lo = p; a.ph_hi = p + 1; hipLaunchKernelGGL(mk, dim3(grid), dim3(NWAVES * 64), LDS_BYTES, stream, a); }
#else
    a.ph_lo = 0; a.ph_hi = NPH; hipLaunchKernelGGL(mk, dim3(grid), dim3(NWAVES * 64), LDS_BYTES, stream, a);
#endif
}
```
